# Optimizing an MI355X kernel written in HIP

```python
import math
import jax, jax.numpy as jnp
from jax import lax
import numpy as np

D_MODEL = 1024
BATCH = 1
SEQ = 16384
DEPTH = 2

CHUNK = 64
Q_BLOCK = 128
A_HEADS = 8
A_HEAD_DIM = 64
A_WIDTH = A_HEADS * A_HEAD_DIM
IDX_HEADS = 8
IDX_DIM = 64
TOPK_MAX = 256
B_WIDTH = 512
B_GROUPS = 8
SHORT_CONV = 3
C_WIDTH = 512
POOL_WINDOWS = (2, 4, 8, 16)
C_GROUPS = len(POOL_WINDOWS)
C_GROUP_DIM = C_WIDTH // C_GROUPS
D_HEADS = 8
D_NOPE = 64
D_ROPE = 32
D_V = 64
Q_LORA = 384
KV_LORA = 256
ROPE_BASE = 10000.0
D_FF = 2816
FFN_CONV = 3
LN_EPS = 1e-5
RMS_EPS = 1e-6
DN_ALPHA = (2 * DEPTH) ** 0.25
DN_BETA = (8 * DEPTH) ** -0.25
NEG = -1e30

EVEN_SIZES = (A_WIDTH, A_WIDTH, A_WIDTH, IDX_HEADS * IDX_DIM, IDX_DIM, IDX_HEADS,
              B_WIDTH, B_WIDTH, B_WIDTH)
EVEN_IN = sum(EVEN_SIZES)
EVEN_OUT = A_WIDTH + B_WIDTH
ODD_SIZES = (C_WIDTH, Q_LORA, KV_LORA, D_ROPE)
ODD_IN = sum(ODD_SIZES)
ODD_OUT = C_WIDTH + D_HEADS * D_V
N_EVEN = (DEPTH + 1) // 2
N_ODD = DEPTH // 2

kernel_name = "hybrid_streaming_dsa_shortconv_pool_mla"


def _split(z, sizes):
    offs = []
    acc = 0
    for s in sizes[:-1]:
        acc += s
        offs.append(acc)
    return jnp.split(z, offs, axis=-1)


def layer_norm(x, g, b):
    x32 = x.astype(jnp.float32)
    mu = jnp.mean(x32, axis=-1, keepdims=True)
    var = jnp.mean(jnp.square(x32 - mu), axis=-1, keepdims=True)
    y = (x32 - mu) * lax.rsqrt(var + LN_EPS)
    return (y * g.astype(jnp.float32) + b.astype(jnp.float32)).astype(x.dtype)


def rms_norm(x, g):
    x32 = x.astype(jnp.float32)
    y = x32 * lax.rsqrt(jnp.mean(jnp.square(x32), axis=-1, keepdims=True) + RMS_EPS)
    return (y * g.astype(jnp.float32)).astype(x.dtype)


def causal_dwconv(x, w):
    k_w = w.shape[0]
    seq = x.shape[1]
    xp = jnp.pad(x, ((0, 0), (k_w - 1, 0), (0, 0)))
    y = xp[:, 0:seq] * w[0]
    for k in range(1, k_w):
        y = y + xp[:, k:k + seq] * w[k]
    return y


def chunk_limit(pos):
    return (pos // CHUNK + 1) * CHUNK


def alibi_slopes(n):
    return jnp.asarray([2.0 ** (-8.0 * (i + 1) / n) for i in range(n)], dtype=jnp.float32)


def rope_tables(seq, dim):
    inv = ROPE_BASE ** (-jnp.arange(0, dim, 2, dtype=jnp.float32) / dim)
    ang = jnp.arange(seq, dtype=jnp.float32)[:, None] * inv[None, :]
    return jnp.cos(ang), jnp.sin(ang)


def apply_rope(x, cos, sin):
    half = x.shape[-1] // 2
    x1, x2 = x[..., :half], x[..., half:]
    c = cos[None, :, None, :].astype(x.dtype)
    s = sin[None, :, None, :].astype(x.dtype)
    return jnp.concatenate([x1 * c - x2 * s, x2 * c + x1 * s], axis=-1)


def dsa_attention(q, k, v, q_idx, k_idx, w_idx):
    bsz, seq = q.shape[0], q.shape[1]
    topk = min(TOPK_MAX, seq // 4)
    nblk = seq // Q_BLOCK
    key_pos = jnp.arange(seq)
    slopes = alibi_slopes(A_HEADS)
    w_scaled = w_idx * (IDX_HEADS ** -0.5 * IDX_DIM ** -0.5)
    scale = A_HEAD_DIM ** -0.5

    def block(i):
        start = i * Q_BLOCK
        qb = lax.dynamic_slice_in_dim(q, start, Q_BLOCK, axis=1)
        qib = lax.dynamic_slice_in_dim(q_idx, start, Q_BLOCK, axis=1)
        wb = lax.dynamic_slice_in_dim(w_scaled, start, Q_BLOCK, axis=1)
        qpos = start + jnp.arange(Q_BLOCK)
        limit = chunk_limit(qpos)
        rel = jax.nn.relu(jnp.einsum('bthd,bsd->bths', qib, k_idx))
        score = jnp.einsum('bths,bth->bts', rel, wb)
        admissible = key_pos[None, :] < limit[:, None]
        score = jnp.where(admissible[None], score, NEG)
        _, idx = lax.top_k(score, topk)
        valid = idx < limit[None, :, None]
        k_sel = jax.vmap(lambda kk, ii: kk[ii])(k, idx)
        v_sel = jax.vmap(lambda vv, ii: vv[ii])(v, idx)
        logits = jnp.einsum('bthd,btjhd->bthj', qb, k_sel).astype(jnp.float32) * scale
        dist = jnp.abs(qpos[None, :, None] - idx).astype(jnp.float32)
        logits = logits - slopes[None, None, :, None] * dist[:, :, None, :]
        logits = jnp.where(valid[:, :, None, :], logits, NEG)
        p = jax.nn.softmax(logits, axis=-1).astype(v.dtype)
        return jnp.einsum('bthj,btjhd->bthd', p, v_sel)

    out = lax.map(block, jnp.arange(nblk))
    return jnp.moveaxis(out, 0, 1).reshape(bsz, seq, A_WIDTH)


def multiscale_pool(u, pool_w, pool_scale):
    bsz, seq = u.shape[0], u.shape[1]
    ug = u.reshape(bsz, seq, C_GROUPS, C_GROUP_DIM)
    cs = jnp.cumsum(ug.astype(jnp.float32), axis=1)
    cs = jnp.pad(cs, ((0, 0), (1, 0), (0, 0), (0, 0)))
    pos = jnp.arange(seq)
    means = []
    for g, win in enumerate(POOL_WINDOWS):
        hi = cs[:, 1:, g]
        lo = cs[:, jnp.maximum(pos + 1 - win, 0), g]
        cnt = jnp.minimum(pos + 1, win).astype(jnp.float32)
        means.append((hi - lo) / cnt[None, :, None])
    pooled = jnp.stack(means, axis=2).astype(u.dtype) - ug
    mixed = jnp.einsum('bsgc,gcd->bsgd', pooled, pool_w)
    return mixed.reshape(bsz, seq, C_WIDTH) * pool_scale


def mla_attention(q_lat, kv_lat, k_rope_in, q_norm_g, w_uq, kv_norm_g, w_ukv):
    bsz, seq = q_lat.shape[0], q_lat.shape[1]
    q = (rms_norm(q_lat, q_norm_g) @ w_uq).reshape(bsz, seq, D_HEADS, D_NOPE + D_ROPE)
    q_nope, q_rope = q[..., :D_NOPE], q[..., D_NOPE:]
    kv = (rms_norm(kv_lat, kv_norm_g) @ w_ukv).reshape(bsz, seq, D_HEADS, D_NOPE + D_V)
    k_nope, v = kv[..., :D_NOPE], kv[..., D_NOPE:]
    cos, sin = rope_tables(seq, D_ROPE)
    q_rope = apply_rope(q_rope, cos, sin)
    k_rope = apply_rope(k_rope_in[:, :, None, :], cos, sin)
    qh = jnp.concatenate([q_nope, q_rope], axis=-1)
    kh = jnp.concatenate([k_nope, jnp.broadcast_to(k_rope, (bsz, seq, D_HEADS, D_ROPE))], axis=-1)
    scale = (D_NOPE + D_ROPE) ** -0.5
    key_pos = jnp.arange(seq)
    nblk = seq // Q_BLOCK

    def block(i):
        start = i * Q_BLOCK
        qb = lax.dynamic_slice_in_dim(qh, start, Q_BLOCK, axis=1)
        limit = chunk_limit(start + jnp.arange(Q_BLOCK))
        logits = jnp.einsum('bthd,bshd->bhts', qb, kh).astype(jnp.float32) * scale
        mask = key_pos[None, :] < limit[:, None]
        logits = jnp.where(mask[None, None], logits, NEG)
        p = jax.nn.softmax(logits, axis=-1).astype(v.dtype)
        return jnp.einsum('bhts,bshd->bthd', p, v)

    out = lax.map(block, jnp.arange(nblk))
    return jnp.moveaxis(out, 0, 1).reshape(bsz, seq, D_HEADS * D_V)


def even_mixer(h, w_in, conv_w, w_out):
    bsz, seq = h.shape[0], h.shape[1]
    z = h @ w_in
    q, k, v, qi, ki, wi, bg, cg, xb = _split(z, EVEN_SIZES)
    ya = dsa_attention(q.reshape(bsz, seq, A_HEADS, A_HEAD_DIM),
                       k.reshape(bsz, seq, A_HEADS, A_HEAD_DIM),
                       v.reshape(bsz, seq, A_HEADS, A_HEAD_DIM),
                       qi.reshape(bsz, seq, IDX_HEADS, IDX_DIM), ki, wi)
    yb = bg * causal_dwconv(cg * xb, conv_w)
    return jnp.concatenate([ya, yb], axis=-1) @ w_out


def odd_mixer(h, w_in, pool_w, pool_scale, q_norm_g, w_uq, kv_norm_g, w_ukv, w_out):
    z = h @ w_in
    u, q_lat, kv_lat, k_rope = _split(z, ODD_SIZES)
    yc = multiscale_pool(u, pool_w, pool_scale)
    yd = mla_attention(q_lat, kv_lat, k_rope, q_norm_g, w_uq, kv_norm_g, w_ukv)
    return jnp.concatenate([yc, yd], axis=-1) @ w_out


def conv_ffn(h, w_up, conv_w, w_down):
    u = causal_dwconv(h @ w_up, conv_w)
    val, gate = u[..., :D_FF], u[..., D_FF:]
    return (jax.nn.silu(gate) * val) @ w_down


def setup_inputs(seed: int = 0) -> dict:
    key = jax.random.key(seed)
    ks = iter(jax.random.split(key, 40))
    f32 = jnp.float32

    def nrm(shape, scale):
        return jax.random.normal(next(ks), shape, f32) * scale

    d = D_MODEL
    x = nrm((BATCH, SEQ, d), 1.0)
    c = nrm((BATCH, d), 1.0)
    ada_w = nrm((DEPTH, d, 6 * d), 0.1 * d ** -0.5)
    ada_b = nrm((DEPTH, 6 * d), 0.01)
    ln_mix_g = 1.0 + nrm((DEPTH, d), 0.01)
    ln_mix_b = nrm((DEPTH, d), 0.01)
    ln_ffn_g = 1.0 + nrm((DEPTH, d), 0.01)
    ln_ffn_b = nrm((DEPTH, d), 0.01)

    even_col_scale = jnp.concatenate([
        jnp.ones((2 * A_WIDTH,), f32), jnp.full((A_WIDTH,), DN_BETA, f32),
        jnp.ones((EVEN_IN - 3 * A_WIDTH,), f32)])
    ev_w_in = nrm((N_EVEN, d, EVEN_IN), d ** -0.5) * even_col_scale
    ev_conv_w = nrm((N_EVEN, SHORT_CONV, B_WIDTH), SHORT_CONV ** -0.5)
    ev_w_out = nrm((N_EVEN, EVEN_OUT, d), DN_BETA * EVEN_OUT ** -0.5)

    od_w_in = nrm((N_ODD, d, ODD_IN), d ** -0.5)
    pool_w = nrm((N_ODD, C_GROUPS, C_GROUP_DIM, C_GROUP_DIM), C_GROUP_DIM ** -0.5)
    pool_scale = 1.0 + nrm((N_ODD, C_WIDTH), 0.1)
    q_norm_g = 1.0 + nrm((N_ODD, Q_LORA), 0.01)
    w_uq = nrm((N_ODD, Q_LORA, D_HEADS * (D_NOPE + D_ROPE)), Q_LORA ** -0.5)
    kv_norm_g = 1.0 + nrm((N_ODD, KV_LORA), 0.01)
    ukv_col_scale = jnp.tile(jnp.concatenate([jnp.ones((D_NOPE,), f32),
                                              jnp.full((D_V,), DN_BETA, f32)]), D_HEADS)
    w_ukv = nrm((N_ODD, KV_LORA, D_HEADS * (D_NOPE + D_V)), KV_LORA ** -0.5) * ukv_col_scale
    od_w_out = nrm((N_ODD, ODD_OUT, d), DN_BETA * ODD_OUT ** -0.5)

    ffn_w_up = nrm((DEPTH, d, 2 * D_FF), d ** -0.5)
    ffn_conv_w = nrm((DEPTH, FFN_CONV, 2 * D_FF), FFN_CONV ** -0.5)
    ffn_w_down = nrm((DEPTH, D_FF, d), DN_BETA * D_FF ** -0.5)

    return {"x": x, "c": c, "ada_w": ada_w, "ada_b": ada_b,
            "ln_mix_g": ln_mix_g, "ln_mix_b": ln_mix_b, "ln_ffn_g": ln_ffn_g, "ln_ffn_b": ln_ffn_b,
            "ev_w_in": ev_w_in, "ev_conv_w": ev_conv_w, "ev_w_out": ev_w_out,
            "od_w_in": od_w_in, "pool_w": pool_w, "pool_scale": pool_scale,
            "q_norm_g": q_norm_g, "w_uq": w_uq, "kv_norm_g": kv_norm_g, "w_ukv": w_ukv,
            "od_w_out": od_w_out,
            "ffn_w_up": ffn_w_up, "ffn_conv_w": ffn_conv_w, "ffn_w_down": ffn_w_down}


def reference(x, c, ada_w, ada_b, ln_mix_g, ln_mix_b, ln_ffn_g, ln_ffn_b,
              ev_w_in, ev_conv_w, ev_w_out,
              od_w_in, pool_w, pool_scale, q_norm_g, w_uq, kv_norm_g, w_ukv, od_w_out,
              ffn_w_up, ffn_conv_w, ffn_w_down):
    cond = jax.nn.silu(c)
    for l in range(DEPTH):
        mod = (cond @ ada_w[l] + ada_b[l])[:, None, :]
        sh_m, sc_m, g_m, sh_f, sc_f, g_f = jnp.split(mod, 6, axis=-1)
        h = x * (1.0 + sc_m) + sh_m
        if l % 2 == 0:
            e = l // 2
            y = even_mixer(h, ev_w_in[e], ev_conv_w[e], ev_w_out[e])
        else:
            o = l // 2
            y = odd_mixer(h, od_w_in[o], pool_w[o], pool_scale[o], q_norm_g[o], w_uq[o],
                          kv_norm_g[o], w_ukv[o], od_w_out[o])
        x = layer_norm(DN_ALPHA * x + (1.0 + g_m) * y, ln_mix_g[l], ln_mix_b[l])
        h = x * (1.0 + sc_f) + sh_f
        y = conv_ffn(h, ffn_w_up[l], ffn_conv_w[l], ffn_w_down[l])
        x = layer_norm(DN_ALPHA * x + (1.0 + g_f) * y, ln_ffn_g[l], ln_ffn_b[l])
    return x
```

```cpp
#include <hip/hip_runtime.h>
#include <cstdint>
#include <cstdio>

typedef unsigned short bf16_t;
typedef _Float16 f16_t;

constexpr int S = 16384, D = 1024;
constexpr int EVEN_IN = 3656, EVEN_IN_P = 3840;
constexpr int ODD_IN = 1184, ODD_IN_P = 1280;
constexpr int DFF = 2816, DFF2 = 5632;
constexpr int TOPK = 256;
constexpr float DN_ALPHA = 1.41421356237309515f;
constexpr float LN_EPS = 1e-5f, RMS_EPS = 1e-6f;
constexpr float MLA_QSCALE = 0.14724444602590306f;

constexpr size_t MiB = 1u << 20;
constexpr size_t WS_CTL = 0;
constexpr size_t WS_MOD = 1 * MiB;
constexpr size_t WS_BIAS_IN0 = 1 * MiB + 64 * 1024;
constexpr size_t WS_BIAS_UP0 = 1 * MiB + 96 * 1024;
constexpr size_t WS_BIAS_IN1 = 1 * MiB + 128 * 1024;
constexpr size_t WS_BIAS_UP1 = 1 * MiB + 160 * 1024;
constexpr size_t WS_RS = 1 * MiB + 256 * 1024;
constexpr size_t WS_ROPE = 2 * MiB;
constexpr size_t WS_W_IN0 = 4 * MiB;
constexpr size_t WS_W_OUT0 = 12 * MiB;
constexpr size_t WS_W_UP0 = 14 * MiB;
constexpr size_t WS_W_DN0 = 25 * MiB;
constexpr size_t WS_W_IN1 = 31 * MiB;
constexpr size_t WS_W_POOL = 34 * MiB;
constexpr size_t WS_W_UQ = 35 * MiB;
constexpr size_t WS_W_UK = 36 * MiB;
constexpr size_t WS_W_UV = 36 * MiB + 512 * 1024;
constexpr size_t WS_W_OUT1 = 37 * MiB;
constexpr size_t WS_W_UP1 = 39 * MiB;
constexpr size_t WS_W_DN1 = 50 * MiB;
constexpr size_t WS_XB = 56 * MiB;
constexpr size_t WS_Q0 = 88 * MiB, WS_K0 = 104 * MiB, WS_V0 = 120 * MiB;
constexpr size_t WS_QI = 136 * MiB;
constexpr size_t WS_BG = 152 * MiB, WS_CG = 168 * MiB, WS_XC = 184 * MiB;
constexpr size_t WS_KI = 200 * MiB;
constexpr size_t WS_WI = 202 * MiB;
constexpr size_t WS_IDX = 203 * MiB;
constexpr size_t WS_Y0 = 212 * MiB;
constexpr size_t WS_G = 88 * MiB;
constexpr size_t WS_HU = 176 * MiB;
constexpr size_t WS_Z1 = 88 * MiB;
constexpr size_t WS_PL = 128 * MiB;
constexpr size_t WS_Q1 = 144 * MiB;
constexpr size_t WS_K1 = 168 * MiB;
constexpr size_t WS_KR = 184 * MiB;
constexpr size_t WS_VT = 186 * MiB;
constexpr size_t WS_Y1 = 202 * MiB;
constexpr size_t WS_END = 256 * MiB;

__device__ __forceinline__ float bf2f(bf16_t h) { return __uint_as_float(((unsigned)h) << 16); }
__device__ __forceinline__ bf16_t f2bf(float f) { unsigned u = __float_as_uint(f); return (bf16_t)((u + 0x7fffu + ((u >> 16) & 1u)) >> 16); }
__device__ __forceinline__ float bflo(unsigned w) { return __uint_as_float(w << 16); }
__device__ __forceinline__ float bfhi(unsigned w) { return __uint_as_float(w & 0xffff0000u); }
__device__ __forceinline__ float wave_sum(float v) {
#pragma unroll
    for (int o = 1; o < 64; o <<= 1) v += __shfl_xor(v, o);
    return v;
}
__device__ __forceinline__ float wave_max(float v) {
#pragma unroll
    for (int o = 1; o < 64; o <<= 1) v = fmaxf(v, __shfl_xor(v, o));
    return v;
}
__device__ __forceinline__ float silu_f(float v) { return v / (1.f + __expf(-v)); }

__constant__ float c_inv_freq[16] = {1.0f, 0.5623413324356079f, 0.3162277638912201f, 0.17782793939113617f, 0.10000000149011612f, 0.05623413249850273f,
    0.03162277489900589f, 0.017782794311642647f, 0.009999999776482582f, 0.005623413249850273f, 0.003162277629598975f, 0.0017782794311642647f,
    0.0010000000474974513f, 0.000562341301701963f, 0.0003162277571391314f, 0.00017782794020604342f};

__global__ void k_mod(const float* __restrict__ c, const float* __restrict__ ada_w, const float* __restrict__ ada_b, float* __restrict__ mod) {
    const int gid = blockIdx.x * blockDim.x + threadIdx.x;
    if (gid >= 2 * 6144) return;
    const int l = gid / 6144, n = gid % 6144;
    const float* w = ada_w + (size_t)l * 1024 * 6144 + n;
    float acc = 0.f;
    for (int k = 0; k < 1024; ++k) acc += silu_f(c[k]) * w[(size_t)k * 6144];
    mod[gid] = acc + ada_b[gid];
}
__global__ void k_rope(float* __restrict__ rope) {
    const int gid = blockIdx.x * blockDim.x + threadIdx.x;
    if (gid >= S * 16) return;
    const int t = gid >> 4, i = gid & 15;
    const float ang = (float)t * c_inv_freq[i];
    double rev = (double)ang * 0.15915494309189535;
    rev -= rint(rev);
    const float f = (float)rev;
    rope[gid] = __builtin_amdgcn_cosf(f);
    rope[S * 16 + gid] = __builtin_amdgcn_sinf(f);
}
__device__ __forceinline__ int src_col(int mode, int n, int Nsrc) {
    if (mode == 0) return n < Nsrc ? n : -1;
    if (mode == 1) { const int tile = n >> 8, i = n & 255; return i < 128 ? tile * 128 + i : DFF + tile * 128 + (i - 128); }
    if (mode == 2) { const int h = n / 96, e = n % 96; if (e < 64) return h * 96 + e; const int i = (e - 64) >> 1; return h * 96 + 64 + ((e & 1) ? 16 + i : i); }
    if (mode == 3) { const int h = n >> 6, d = n & 63; return h * 128 + d; }
    { const int h = n >> 6, d = n & 63; return h * 128 + 64 + d; }
}
__global__ void k_prep_w(const float* __restrict__ W, int K, int Nsrc, int Npad, int mode, const float* __restrict__ rowscale1p, const float* __restrict__ rowscale,
                         const float* __restrict__ colscale1p, float cst, bf16_t* __restrict__ dst) {
    const size_t gid = (size_t)blockIdx.x * blockDim.x + threadIdx.x;
    if (gid >= (size_t)Npad * K) return;
    const int n = (int)(gid / K), k = (int)(gid % K);
    const int sn = src_col(mode, n, Nsrc);
    float v = 0.f;
    if (sn >= 0) {
        v = W[(size_t)k * Nsrc + sn] * cst;
        if (rowscale1p) v *= 1.f + rowscale1p[k];
        if (rowscale) v *= rowscale[k];
        if (colscale1p) v *= 1.f + colscale1p[sn];
    }
    dst[gid] = f2bf(v);
}
__global__ void k_prep_bias(const float* __restrict__ W, int K, int Nsrc, int Npad, int mode, const float* __restrict__ shift, float* __restrict__ bias) {
    const int n = blockIdx.x * blockDim.x + threadIdx.x;
    if (n >= Npad) return;
    const int sn = src_col(mode, n, Nsrc);
    float acc = 0.f;
    if (sn >= 0) for (int k = 0; k < K; ++k) acc += shift[k] * W[(size_t)k * Nsrc + sn];
    bias[n] = acc;
}
__global__ void k_prep_pool(const float* __restrict__ pool_w, const float* __restrict__ pool_scale, bf16_t* __restrict__ dst) {
    const int gid = blockIdx.x * blockDim.x + threadIdx.x;
    if (gid >= 512 * 512) return;
    const int n = gid >> 9, k = gid & 511, g = n >> 7, d = n & 127;
    float v = 0.f;
    if ((k >> 7) == g) v = pool_w[((size_t)g * 128 + (k & 127)) * 128 + d] * pool_scale[n];
    dst[gid] = f2bf(v);
}
__global__ void k_cvt_x(const float* __restrict__ x, bf16_t* __restrict__ xb) {
    const size_t gid = (size_t)blockIdx.x * blockDim.x + threadIdx.x;
    if (gid >= (size_t)S * D) return;
    xb[gid] = f2bf(x[gid]);
}

template <class Epi>
__global__ void __launch_bounds__(256) k_gemm(const bf16_t* __restrict__ A, int lda, const bf16_t* __restrict__ Bt, int ldb, int K, Epi epi) {
    const int tx = threadIdx.x & 15, ty = threadIdx.x >> 4;
    const int row0 = blockIdx.y * 64 + ty * 4, col0 = blockIdx.x * 64 + tx * 4;
    float acc[4][4];
#pragma unroll
    for (int i = 0; i < 4; ++i)
#pragma unroll
        for (int j = 0; j < 4; ++j) acc[i][j] = 0.f;
    for (int k = 0; k < K; k += 8) {
        uint4 a[4], b[4];
#pragma unroll
        for (int i = 0; i < 4; ++i) a[i] = *(const uint4*)(A + (size_t)(row0 + i) * lda + k);
#pragma unroll
        for (int j = 0; j < 4; ++j) b[j] = *(const uint4*)(Bt + (size_t)(col0 + j) * ldb + k);
#pragma unroll
        for (int i = 0; i < 4; ++i)
#pragma unroll
            for (int j = 0; j < 4; ++j) {
                acc[i][j] += bflo(a[i].x) * bflo(b[j].x) + bfhi(a[i].x) * bfhi(b[j].x) + bflo(a[i].y) * bflo(b[j].y) + bfhi(a[i].y) * bfhi(b[j].y)
                           + bflo(a[i].z) * bflo(b[j].z) + bfhi(a[i].z) * bfhi(b[j].z) + bflo(a[i].w) * bflo(b[j].w) + bfhi(a[i].w) * bfhi(b[j].w);
            }
    }
#pragma unroll
    for (int i = 0; i < 4; ++i) epi.store4(row0 + i, col0, acc[i][0], acc[i][1], acc[i][2], acc[i][3]);
}

__device__ __forceinline__ void st_bf16x4(bf16_t* p, float a, float b, float c, float d) {
    uint2 w; w.x = (unsigned)f2bf(a) | ((unsigned)f2bf(b) << 16); w.y = (unsigned)f2bf(c) | ((unsigned)f2bf(d) << 16); *(uint2*)p = w;
}
struct EpiIn0 {
    const float* bias; bf16_t *q, *k, *v, *bg, *cg, *xc; f16_t *qi, *ki; float* wi;
    __device__ __forceinline__ void store4(int r, int c, float a, float b, float cc, float d) const {
        if (c >= EVEN_IN) return;
        const float4 bv = *(const float4*)(bias + c); a += bv.x; b += bv.y; cc += bv.z; d += bv.w;
        if (c < 512) { st_bf16x4(q + (size_t)r * 512 + c, a * 0.125f, b * 0.125f, cc * 0.125f, d * 0.125f); return; }
        if (c < 1024) { st_bf16x4(k + (size_t)r * 512 + (c - 512), a, b, cc, d); return; }
        if (c < 1536) { st_bf16x4(v + (size_t)r * 512 + (c - 1024), a, b, cc, d); return; }
        if (c < 2048) { f16_t* p = qi + (size_t)r * 512 + (c - 1536); p[0] = (f16_t)a; p[1] = (f16_t)b; p[2] = (f16_t)cc; p[3] = (f16_t)d; return; }
        if (c < 2112) { f16_t* p = ki + (size_t)r * 64 + (c - 2048); p[0] = (f16_t)a; p[1] = (f16_t)b; p[2] = (f16_t)cc; p[3] = (f16_t)d; return; }
        if (c < 2120) { *(float4*)(wi + (size_t)r * 8 + (c - 2112)) = make_float4(a, b, cc, d); return; }
        if (c < 2632) { st_bf16x4(bg + (size_t)r * 512 + (c - 2120), a, b, cc, d); return; }
        if (c < 3144) { st_bf16x4(cg + (size_t)r * 512 + (c - 2632), a, b, cc, d); return; }
        st_bf16x4(xc + (size_t)r * 512 + (c - 3144), a, b, cc, d);
    }
};
struct EpiResid {
    const float* res; float* pre;
    __device__ __forceinline__ void store4(int r, int c, float a, float b, float cc, float d) const {
        const float4 x = *(const float4*)(res + (size_t)r * D + c);
        *(float4*)(pre + (size_t)r * D + c) = make_float4(DN_ALPHA * x.x + a, DN_ALPHA * x.y + b, DN_ALPHA * x.z + cc, DN_ALPHA * x.w + d);
    }
};
struct EpiBiasBf16 {
    const float* bias; bf16_t* out; int ldc;
    __device__ __forceinline__ void store4(int r, int c, float a, float b, float cc, float d) const {
        const float4 bv = *(const float4*)(bias + c);
        st_bf16x4(out + (size_t)r * ldc + c, a + bv.x, b + bv.y, cc + bv.z, d + bv.w);
    }
};
struct EpiPlainBf16 {
    bf16_t* out; int ldc;
    __device__ __forceinline__ void store4(int r, int c, float a, float b, float cc, float d) const { st_bf16x4(out + (size_t)r * ldc + c, a, b, cc, d); }
};
struct EpiRowScaleBf16 {
    const float* rs; int which; bf16_t* out; int ldc;
    __device__ __forceinline__ void store4(int r, int c, float a, float b, float cc, float d) const {
        const float s = rs[(size_t)r * 2 + which]; st_bf16x4(out + (size_t)r * ldc + c, a * s, b * s, cc * s, d * s);
    }
};
struct EpiColScaleBf16 {
    const float* rs; int which; bf16_t* out; int ldc;
    __device__ __forceinline__ void store4(int r, int c, float a, float b, float cc, float d) const {
        st_bf16x4(out + (size_t)r * ldc + c, a * rs[(size_t)c * 2 + which], b * rs[(size_t)(c + 1) * 2 + which], cc * rs[(size_t)(c + 2) * 2 + which], d * rs[(size_t)(c + 3) * 2 + which]);
    }
};
struct EpiQ1 {
    const float* rs; const float* rope; bf16_t* out;
    __device__ __forceinline__ void store4(int r, int c, float a, float b, float cc, float d) const {
        const float s = rs[(size_t)r * 2]; a *= s; b *= s; cc *= s; d *= s;
        const int e = c % 96;
        if (e >= 64) {
            const int i = (e - 64) >> 1;
            const float c0 = rope[(size_t)r * 16 + i], s0 = rope[(size_t)S * 16 + (size_t)r * 16 + i];
            const float c1 = rope[(size_t)r * 16 + i + 1], s1 = rope[(size_t)S * 16 + (size_t)r * 16 + i + 1];
            const float a2 = a * c0 - b * s0, b2 = b * c0 + a * s0, c2 = cc * c1 - d * s1, d2 = d * c1 + cc * s1;
            a = a2; b = b2; cc = c2; d = d2;
        }
        st_bf16x4(out + (size_t)r * 768 + c, a, b, cc, d);
    }
};

__global__ void __launch_bounds__(256) k_ln(float* __restrict__ pre, const float* __restrict__ g, const float* __restrict__ b, bf16_t* __restrict__ xb) {
    const int lane = threadIdx.x & 63, row = blockIdx.x * 4 + (threadIdx.x >> 6);
    float4* xr = (float4*)(pre + (size_t)row * D) + lane;
    float4 v[4]; float s = 0.f;
#pragma unroll
    for (int j = 0; j < 4; ++j) { v[j] = xr[64 * j]; s += (v[j].x + v[j].y) + (v[j].z + v[j].w); }
    const float mean = wave_sum(s) * (1.f / D); float s2 = 0.f;
#pragma unroll
    for (int j = 0; j < 4; ++j) { v[j].x -= mean; v[j].y -= mean; v[j].z -= mean; v[j].w -= mean; s2 += (v[j].x * v[j].x + v[j].y * v[j].y) + (v[j].z * v[j].z + v[j].w * v[j].w); }
    const float rstd = 1.f / sqrtf(wave_sum(s2) * (1.f / D) + LN_EPS);
#pragma unroll
    for (int j = 0; j < 4; ++j) {
        const float4 gg = ((const float4*)g)[64 * j + lane], bb = ((const float4*)b)[64 * j + lane];
        float4 o; o.x = v[j].x * rstd * gg.x + bb.x; o.y = v[j].y * rstd * gg.y + bb.y; o.z = v[j].z * rstd * gg.z + bb.z; o.w = v[j].w * rstd * gg.w + bb.w;
        xr[64 * j] = o;
        st_bf16x4(xb + (size_t)row * D + (64 * j + lane) * 4, o.x, o.y, o.z, o.w);
    }
}

__global__ void __launch_bounds__(256) k_topk(const f16_t* __restrict__ qi, const f16_t* __restrict__ ki, const float* __restrict__ wi, unsigned short* __restrict__ idx) {
    extern __shared__ __attribute__((aligned(16))) unsigned char smem[];
    unsigned* key = (unsigned*)smem;
    float* qs = (float*)(smem + 65536);
    __shared__ unsigned s_cnt, s_wc[4];
    const int t = blockIdx.x, tid = threadIdx.x, N = (t / 64 + 1) * 64;
    unsigned short* out = idx + (size_t)t * TOPK;
    if (N <= TOPK) { if (tid < N) out[tid] = (unsigned short)tid; return; }
    for (int i = tid; i < 512; i += 256) qs[i] = (float)qi[(size_t)t * 512 + i];
    float w[8];
#pragma unroll
    for (int h = 0; h < 8; ++h) w[h] = wi[(size_t)t * 8 + h];
    __syncthreads();
    for (int s = tid; s < N; s += 256) {
        float kf[64];
        const uint4* kp = (const uint4*)(ki + (size_t)s * 64);
#pragma unroll
        for (int j = 0; j < 8; ++j) { const uint4 u = kp[j]; const f16_t* hp = (const f16_t*)&u;
#pragma unroll
            for (int e = 0; e < 8; ++e) kf[j * 8 + e] = (float)hp[e]; }
        float sc = 0.f;
#pragma unroll
        for (int h = 0; h < 8; ++h) { float d = 0.f;
#pragma unroll
            for (int e = 0; e < 64; ++e) d += qs[h * 64 + e] * kf[e];
            sc += w[h] * fmaxf(d, 0.f); }
        unsigned u = __float_as_uint(sc); u = (u & 0x80000000u) ? ~u : (u | 0x80000000u);
        key[s] = u;
    }
    __syncthreads();
    unsigned T = 0;
    for (int bit = 31; bit >= 0; --bit) {
        const unsigned cand = T | (1u << bit);
        if (tid == 0) s_cnt = 0;
        __syncthreads();
        unsigned c = 0;
        for (int s = tid; s < N; s += 256) c += (key[s] >= cand) ? 1u : 0u;
        atomicAdd(&s_cnt, c);
        __syncthreads();
        if (s_cnt >= (unsigned)TOPK) T = cand;
        __syncthreads();
    }
    if (tid == 0) s_cnt = 0;
    __syncthreads();
    for (int s = tid; s < N; s += 256) if (key[s] > T) { const unsigned p = atomicAdd(&s_cnt, 1u); out[p] = (unsigned short)s; }
    __syncthreads();
    const unsigned ngt = s_cnt, need = TOPK - ngt;
    __syncthreads();
    unsigned base = 0;
    const int wv = tid >> 6, lane = tid & 63;
    for (int s0 = 0; s0 < N; s0 += 256) {
        const int s = s0 + tid;
        const bool eq = (s < N) && (key[s] == T);
        const unsigned long long m = __ballot(eq);
        if (lane == 0) s_wc[wv] = (unsigned)__popcll(m);
        __syncthreads();
        unsigned r = base;
        for (int q = 0; q < wv; ++q) r += s_wc[q];
        r += (unsigned)__popcll(m & ((1ull << lane) - 1ull));
        if (eq && r < need) out[ngt + r] = (unsigned short)s;
        base += s_wc[0] + s_wc[1] + s_wc[2] + s_wc[3];
        __syncthreads();
    }
}

__global__ void __launch_bounds__(256) k_dsa_attn(const bf16_t* __restrict__ q, const bf16_t* __restrict__ k, const bf16_t* __restrict__ v, const unsigned short* __restrict__ idx, bf16_t* __restrict__ y) {
    __shared__ float p[8][256];
    __shared__ float qs[512];
    __shared__ int sid[256];
    __shared__ float red[8][2];
    const int t = blockIdx.x, tid = threadIdx.x;
    const int N = (t / 64 + 1) * 64, cnt = N < TOPK ? N : TOPK;
    for (int i = tid; i < 512; i += 256) qs[i] = bf2f(q[(size_t)t * 512 + i]);
    const int id = tid < cnt ? (int)idx[(size_t)t * TOPK + tid] : 0;
    sid[tid] = id;
    __syncthreads();
    if (tid < cnt) {
        const float dist = fabsf((float)(t - id));
        const uint4* kp = (const uint4*)(k + (size_t)id * 512);
#pragma unroll
        for (int h = 0; h < 8; ++h) {
            float d = 0.f;
#pragma unroll
            for (int j = 0; j < 8; ++j) { const uint4 u = kp[h * 8 + j]; const float* qq = qs + h * 64 + j * 8;
                d += qq[0] * bflo(u.x) + qq[1] * bfhi(u.x) + qq[2] * bflo(u.y) + qq[3] * bfhi(u.y) + qq[4] * bflo(u.z) + qq[5] * bfhi(u.z) + qq[6] * bflo(u.w) + qq[7] * bfhi(u.w); }
            p[h][tid] = d - exp2f(-(float)(h + 1)) * dist;
        }
    }
    __syncthreads();
    if (tid < 8) {
        float m = -3.0e38f;
        for (int j = 0; j < cnt; ++j) m = fmaxf(m, p[tid][j]);
        float s = 0.f;
        for (int j = 0; j < cnt; ++j) s += __expf(p[tid][j] - m);
        red[tid][0] = m; red[tid][1] = 1.f / s;
    }
    __syncthreads();
    if (tid < cnt) {
#pragma unroll
        for (int h = 0; h < 8; ++h) p[h][tid] = __expf(p[h][tid] - red[h][0]) * red[h][1];
    }
    __syncthreads();
#pragma unroll
    for (int half = 0; half < 2; ++half) {
        const int c = tid + half * 256, h = c >> 6;
        float acc = 0.f;
        for (int j = 0; j < cnt; ++j) acc += p[h][j] * bf2f(v[(size_t)sid[j] * 512 + c]);
        y[(size_t)t * 1024 + c] = f2bf(acc);
    }
}
__global__ void k_shortconv(const bf16_t* __restrict__ bg, const bf16_t* __restrict__ cg, const bf16_t* __restrict__ xc, const float* __restrict__ cw, bf16_t* __restrict__ y) {
    const size_t gid = (size_t)blockIdx.x * blockDim.x + threadIdx.x;
    if (gid >= (size_t)S * 512) return;
    const int t = (int)(gid >> 9), c = (int)(gid & 511);
    float acc = 0.f;
#pragma unroll
    for (int kk = 0; kk < 3; ++kk) { const int tt = t - 2 + kk; if (tt >= 0) acc += cw[kk * 512 + c] * bf2f(cg[(size_t)tt * 512 + c]) * bf2f(xc[(size_t)tt * 512 + c]); }
    y[(size_t)t * 1024 + 512 + c] = f2bf(bf2f(bg[gid]) * acc);
}
__global__ void __launch_bounds__(256) k_ffn_up(const bf16_t* __restrict__ xb, const bf16_t* __restrict__ wup, const float* __restrict__ bias, const float* __restrict__ cw, bf16_t* __restrict__ g) {
    const int j = blockIdx.x * 256 + threadIdx.x, t0 = blockIdx.y * 8;
    const int nv = 256 * (j >> 7) + (j & 127), ng = nv + 128;
    float uv[10], ug[10];
#pragma unroll
    for (int i = 0; i < 10; ++i) { uv[i] = 0.f; ug[i] = 0.f; }
    const bf16_t* wv = wup + (size_t)nv * D; const bf16_t* wg = wup + (size_t)ng * D;
    for (int k = 0; k < D; k += 8) {
        const uint4 a = *(const uint4*)(wv + k), b = *(const uint4*)(wg + k);
#pragma unroll
        for (int i = 0; i < 10; ++i) {
            int r = t0 - 2 + i; if (r < 0) r = 0;
            const uint4 x = *(const uint4*)(xb + (size_t)r * D + k);
            uv[i] += bflo(x.x) * bflo(a.x) + bfhi(x.x) * bfhi(a.x) + bflo(x.y) * bflo(a.y) + bfhi(x.y) * bfhi(a.y) + bflo(x.z) * bflo(a.z) + bfhi(x.z) * bfhi(a.z) + bflo(x.w) * bflo(a.w) + bfhi(x.w) * bfhi(a.w);
            ug[i] += bflo(x.x) * bflo(b.x) + bfhi(x.x) * bfhi(b.x) + bflo(x.y) * bflo(b.y) + bfhi(x.y) * bfhi(b.y) + bflo(x.z) * bflo(b.z) + bfhi(x.z) * bfhi(b.z) + bflo(x.w) * bflo(b.w) + bfhi(x.w) * bfhi(b.w);
        }
    }
    const float bv = bias[nv], bgt = bias[ng];
#pragma unroll
    for (int i = 0; i < 10; ++i) { const bool ok = (t0 - 2 + i) >= 0; uv[i] = ok ? uv[i] + bv : 0.f; ug[i] = ok ? ug[i] + bgt : 0.f; }
    const float cv0 = cw[j], cv1 = cw[DFF2 + j], cv2 = cw[2 * DFF2 + j];
    const float cg0 = cw[DFF + j], cg1 = cw[DFF2 + DFF + j], cg2 = cw[2 * DFF2 + DFF + j];
#pragma unroll
    for (int i = 0; i < 8; ++i) {
        const float val = cv0 * uv[i] + cv1 * uv[i + 1] + cv2 * uv[i + 2];
        const float gat = cg0 * ug[i] + cg1 * ug[i + 1] + cg2 * ug[i + 2];
        g[(size_t)(t0 + i) * DFF + j] = f2bf(silu_f(gat) * val);
    }
}
__global__ void __launch_bounds__(256) k_l1_prep(const bf16_t* __restrict__ z1, const float* __restrict__ rope, bf16_t* __restrict__ pl, float* __restrict__ rs, bf16_t* __restrict__ kr) {
    const int t = blockIdx.x, tid = threadIdx.x;
    __shared__ float red[4];
#pragma unroll
    for (int half = 0; half < 2; ++half) {
        const int c = tid + half * 256, gidx = c >> 7, win = 2 << gidx;
        const int lo = (t + 1 - win) > 0 ? (t + 1 - win) : 0, cnt = t + 1 - lo;
        float s = 0.f;
        for (int r = lo; r <= t; ++r) s += bf2f(z1[(size_t)r * ODD_IN_P + c]);
        pl[(size_t)t * 512 + c] = f2bf(s / (float)cnt - bf2f(z1[(size_t)t * ODD_IN_P + c]));
    }
    float sq = 0.f;
    for (int c = tid; c < 384; c += 256) { const float vv = bf2f(z1[(size_t)t * ODD_IN_P + 512 + c]); sq += vv * vv; }
    sq = wave_sum(sq);
    if ((tid & 63) == 0) red[tid >> 6] = sq;
    __syncthreads();
    if (tid == 0) rs[(size_t)t * 2] = 1.f / sqrtf((red[0] + red[1] + red[2] + red[3]) * (1.f / 384.f) + RMS_EPS);
    __syncthreads();
    { const float vv = bf2f(z1[(size_t)t * ODD_IN_P + 896 + tid]); float s2 = wave_sum(vv * vv);
      if ((tid & 63) == 0) red[tid >> 6] = s2; }
    __syncthreads();
    if (tid == 0) rs[(size_t)t * 2 + 1] = 1.f / sqrtf((red[0] + red[1] + red[2] + red[3]) * (1.f / 256.f) + RMS_EPS);
    if (tid < 16) {
        const float x1 = bf2f(z1[(size_t)t * ODD_IN_P + 1152 + tid]), x2 = bf2f(z1[(size_t)t * ODD_IN_P + 1168 + tid]);
        const float c = rope[(size_t)t * 16 + tid], s = rope[(size_t)S * 16 + (size_t)t * 16 + tid];
        kr[(size_t)t * 32 + 2 * tid] = f2bf(x1 * c - x2 * s);
        kr[(size_t)t * 32 + 2 * tid + 1] = f2bf(x2 * c + x1 * s);
    }
}
__global__ void __launch_bounds__(256) k_mla_attn(const bf16_t* __restrict__ q1, const bf16_t* __restrict__ k1, const bf16_t* __restrict__ kr, const bf16_t* __restrict__ vt, bf16_t* __restrict__ y) {
    extern __shared__ __attribute__((aligned(16))) unsigned char smem[];
    float* lg = (float*)smem;
    __shared__ float qs[96];
    __shared__ float red[4];
    const int t = blockIdx.x, h = blockIdx.y, tid = threadIdx.x, lane = tid & 63, wv = tid >> 6;
    const int N = (t / 64 + 1) * 64;
    if (tid < 96) qs[tid] = bf2f(q1[(size_t)t * 768 + h * 96 + tid]);
    __syncthreads();
    float m = -3.0e38f;
    for (int s = tid; s < N; s += 256) {
        const uint4* kp = (const uint4*)(k1 + (size_t)s * 512 + h * 64);
        float d = 0.f;
#pragma unroll
        for (int j = 0; j < 8; ++j) { const uint4 u = kp[j]; const float* qq = qs + j * 8;
            d += qq[0] * bflo(u.x) + qq[1] * bfhi(u.x) + qq[2] * bflo(u.y) + qq[3] * bfhi(u.y) + qq[4] * bflo(u.z) + qq[5] * bfhi(u.z) + qq[6] * bflo(u.w) + qq[7] * bfhi(u.w); }
        const uint4* rp = (const uint4*)(kr + (size_t)s * 32);
#pragma unroll
        for (int j = 0; j < 4; ++j) { const uint4 u = rp[j]; const float* qq = qs + 64 + j * 8;
            d += qq[0] * bflo(u.x) + qq[1] * bfhi(u.x) + qq[2] * bflo(u.y) + qq[3] * bfhi(u.y) + qq[4] * bflo(u.z) + qq[5] * bfhi(u.z) + qq[6] * bflo(u.w) + qq[7] * bfhi(u.w); }
        lg[s] = d; m = fmaxf(m, d);
    }
    m = wave_max(m);
    if (lane == 0) red[wv] = m;
    __syncthreads();
    m = fmaxf(fmaxf(red[0], red[1]), fmaxf(red[2], red[3]));
    __syncthreads();
    float sum = 0.f;
    for (int s = tid; s < N; s += 256) { const float pp = exp2f(lg[s] - m); lg[s] = pp; sum += pp; }
    sum = wave_sum(sum);
    if (lane == 0) red[wv] = sum;
    __syncthreads();
    const float inv = 1.f / (red[0] + red[1] + red[2] + red[3]);
    for (int dd = 0; dd < 16; ++dd) {
        const int d = wv * 16 + dd;
        const bf16_t* vp = vt + (size_t)(h * 64 + d) * S;
        float acc = 0.f;
        for (int s = lane; s < N; s += 64) acc += lg[s] * bf2f(vp[s]);
        acc = wave_sum(acc);
        if (lane == 0) y[(size_t)t * 1024 + 512 + h * 64 + d] = f2bf(acc * inv);
    }
}

template <class Epi>
static void launch_gemm(hipStream_t st, const bf16_t* A, int lda, const bf16_t* Bt, int ldb, int M, int N, int K, const Epi& e) {
    hipLaunchKernelGGL((k_gemm<Epi>), dim3(N / 64, M / 64), dim3(256), 0, st, A, lda, Bt, ldb, K, e);
}

extern "C" void kernel_launch(void* const* d_in, const int* in_sizes, int n_in, void* d_out, int out_size, void* d_ws, size_t ws_size, hipStream_t stream) {
    if (n_in != 22 || out_size != S * D || ws_size < WS_END) { fprintf(stderr, "kernel_launch: unexpected problem (n_in %d out %d ws %zu)\n", n_in, out_size, ws_size); return; }
    const float* x = (const float*)d_in[0]; const float* c = (const float*)d_in[1]; const float* ada_w = (const float*)d_in[2]; const float* ada_b = (const float*)d_in[3];
    const float* ln_mix_g = (const float*)d_in[4]; const float* ln_mix_b = (const float*)d_in[5]; const float* ln_ffn_g = (const float*)d_in[6]; const float* ln_ffn_b = (const float*)d_in[7];
    const float* ev_w_in = (const float*)d_in[8]; const float* ev_conv_w = (const float*)d_in[9]; const float* ev_w_out = (const float*)d_in[10];
    const float* od_w_in = (const float*)d_in[11]; const float* pool_w = (const float*)d_in[12]; const float* pool_scale = (const float*)d_in[13];
    const float* q_norm_g = (const float*)d_in[14]; const float* w_uq = (const float*)d_in[15]; const float* kv_norm_g = (const float*)d_in[16]; const float* w_ukv = (const float*)d_in[17];
    const float* od_w_out = (const float*)d_in[18]; const float* ffn_w_up = (const float*)d_in[19]; const float* ffn_conv_w = (const float*)d_in[20]; const float* ffn_w_down = (const float*)d_in[21];
    unsigned char* ws = (unsigned char*)d_ws;
    float* out = (float*)d_out;
    float* mod = (float*)(ws + WS_MOD); float* rope = (float*)(ws + WS_ROPE); float* rs = (float*)(ws + WS_RS);
    float* bias_in0 = (float*)(ws + WS_BIAS_IN0); float* bias_up0 = (float*)(ws + WS_BIAS_UP0); float* bias_in1 = (float*)(ws + WS_BIAS_IN1); float* bias_up1 = (float*)(ws + WS_BIAS_UP1);
    bf16_t* w_in0 = (bf16_t*)(ws + WS_W_IN0); bf16_t* w_out0 = (bf16_t*)(ws + WS_W_OUT0); bf16_t* w_up0 = (bf16_t*)(ws + WS_W_UP0); bf16_t* w_dn0 = (bf16_t*)(ws + WS_W_DN0);
    bf16_t* w_in1 = (bf16_t*)(ws + WS_W_IN1); bf16_t* w_pool = (bf16_t*)(ws + WS_W_POOL); bf16_t* w_uqb = (bf16_t*)(ws + WS_W_UQ); bf16_t* w_uk = (bf16_t*)(ws + WS_W_UK); bf16_t* w_uv = (bf16_t*)(ws + WS_W_UV);
    bf16_t* w_out1 = (bf16_t*)(ws + WS_W_OUT1); bf16_t* w_up1 = (bf16_t*)(ws + WS_W_UP1); bf16_t* w_dn1 = (bf16_t*)(ws + WS_W_DN1);
    bf16_t* xb = (bf16_t*)(ws + WS_XB);
    bf16_t* q0 = (bf16_t*)(ws + WS_Q0); bf16_t* k0 = (bf16_t*)(ws + WS_K0); bf16_t* v0 = (bf16_t*)(ws + WS_V0); f16_t* qi = (f16_t*)(ws + WS_QI); f16_t* ki = (f16_t*)(ws + WS_KI); float* wi = (float*)(ws + WS_WI);
    bf16_t* bg = (bf16_t*)(ws + WS_BG); bf16_t* cg = (bf16_t*)(ws + WS_CG); bf16_t* xc = (bf16_t*)(ws + WS_XC); unsigned short* idx = (unsigned short*)(ws + WS_IDX); bf16_t* y0 = (bf16_t*)(ws + WS_Y0);
    bf16_t* g = (bf16_t*)(ws + WS_G);
    bf16_t* z1 = (bf16_t*)(ws + WS_Z1); bf16_t* pl = (bf16_t*)(ws + WS_PL); bf16_t* q1 = (bf16_t*)(ws + WS_Q1); bf16_t* k1 = (bf16_t*)(ws + WS_K1); bf16_t* kr = (bf16_t*)(ws + WS_KR);
    bf16_t* vt = (bf16_t*)(ws + WS_VT); bf16_t* y1 = (bf16_t*)(ws + WS_Y1);

    static bool attr_done = false;
    if (!attr_done) {
        (void)hipFuncSetAttribute((const void*)k_topk, hipFuncAttributeMaxDynamicSharedMemorySize, 65536 + 2048);
        (void)hipFuncSetAttribute((const void*)k_mla_attn, hipFuncAttributeMaxDynamicSharedMemorySize, 65536);
        attr_done = true;
    }
    auto prep_w = [&](const float* W, int K, int Nsrc, int Npad, int mode, const float* rs1p, const float* rsc, const float* cs1p, float cst, bf16_t* dst) {
        const size_t n = (size_t)Npad * K; hipLaunchKernelGGL(k_prep_w, dim3((unsigned)((n + 255) / 256)), dim3(256), 0, stream, W, K, Nsrc, Npad, mode, rs1p, rsc, cs1p, cst, dst);
    };
    auto prep_b = [&](const float* W, int K, int Nsrc, int Npad, int mode, const float* shift, float* bias) {
        hipLaunchKernelGGL(k_prep_bias, dim3((Npad + 255) / 256), dim3(256), 0, stream, W, K, Nsrc, Npad, mode, shift, bias);
    };
    hipLaunchKernelGGL(k_mod, dim3(48), dim3(256), 0, stream, c, ada_w, ada_b, mod);
    hipLaunchKernelGGL(k_rope, dim3(S * 16 / 256), dim3(256), 0, stream, rope);
    const float* m0 = mod; const float* m1 = mod + 6144;
    prep_w(ev_w_in, 1024, EVEN_IN, EVEN_IN_P, 0, m0 + 1024, nullptr, nullptr, 1.f, w_in0);  prep_b(ev_w_in, 1024, EVEN_IN, EVEN_IN_P, 0, m0, bias_in0);
    prep_w(ev_w_out, 1024, 1024, 1024, 0, nullptr, nullptr, m0 + 2048, 1.f, w_out0);
    prep_w(ffn_w_up, 1024, DFF2, DFF2, 1, m0 + 4096, nullptr, nullptr, 1.f, w_up0);        prep_b(ffn_w_up, 1024, DFF2, DFF2, 1, m0 + 3072, bias_up0);
    prep_w(ffn_w_down, DFF, 1024, 1024, 0, nullptr, nullptr, m0 + 5120, 1.f, w_dn0);
    prep_w(od_w_in, 1024, ODD_IN, ODD_IN_P, 0, m1 + 1024, nullptr, nullptr, 1.f, w_in1);   prep_b(od_w_in, 1024, ODD_IN, ODD_IN_P, 0, m1, bias_in1);
    hipLaunchKernelGGL(k_prep_pool, dim3(1024), dim3(256), 0, stream, pool_w, pool_scale, w_pool);
    prep_w(w_uq, 384, 768, 768, 2, nullptr, q_norm_g, nullptr, MLA_QSCALE, w_uqb);
    prep_w(w_ukv, 256, 1024, 512, 3, nullptr, kv_norm_g, nullptr, 1.f, w_uk);
    prep_w(w_ukv, 256, 1024, 512, 4, nullptr, kv_norm_g, nullptr, 1.f, w_uv);
    prep_w(od_w_out, 1024, 1024, 1024, 0, nullptr, nullptr, m1 + 2048, 1.f, w_out1);
    prep_w(ffn_w_up + (size_t)1024 * DFF2, 1024, DFF2, DFF2, 1, m1 + 4096, nullptr, nullptr, 1.f, w_up1);  prep_b(ffn_w_up + (size_t)1024 * DFF2, 1024, DFF2, DFF2, 1, m1 + 3072, bias_up1);
    prep_w(ffn_w_down + (size_t)DFF * 1024, DFF, 1024, 1024, 0, nullptr, nullptr, m1 + 5120, 1.f, w_dn1);
    hipLaunchKernelGGL(k_cvt_x, dim3(S * D / 256), dim3(256), 0, stream, x, xb);
    launch_gemm(stream, xb, D, w_in0, D, S, EVEN_IN_P, D, EpiIn0{bias_in0, q0, k0, v0, bg, cg, xc, qi, ki, wi});
    hipLaunchKernelGGL(k_topk, dim3(S), dim3(256), 65536 + 2048, stream, qi, ki, wi, idx);
    hipLaunchKernelGGL(k_dsa_attn, dim3(S), dim3(256), 0, stream, q0, k0, v0, idx, y0);
    hipLaunchKernelGGL(k_shortconv, dim3(S * 512 / 256), dim3(256), 0, stream, bg, cg, xc, ev_conv_w, y0);
    launch_gemm(stream, y0, D, w_out0, D, S, D, D, EpiResid{x, out});
    hipLaunchKernelGGL(k_ln, dim3(S / 4), dim3(256), 0, stream, out, ln_mix_g, ln_mix_b, xb);
    hipLaunchKernelGGL(k_ffn_up, dim3(DFF / 256, S / 8), dim3(256), 0, stream, xb, w_up0, bias_up0, ffn_conv_w, g);
    launch_gemm(stream, g, DFF, w_dn0, DFF, S, D, DFF, EpiResid{out, out});
    hipLaunchKernelGGL(k_ln, dim3(S / 4), dim3(256), 0, stream, out, ln_ffn_g, ln_ffn_b, xb);
    launch_gemm(stream, xb, D, w_in1, D, S, ODD_IN_P, D, EpiBiasBf16{bias_in1, z1, ODD_IN_P});
    hipLaunchKernelGGL(k_l1_prep, dim3(S), dim3(256), 0, stream, z1, rope, pl, rs, kr);
    launch_gemm(stream, pl, 512, w_pool, 512, S, 512, 512, EpiPlainBf16{y1, 1024});
    launch_gemm(stream, z1 + 512, ODD_IN_P, w_uqb, 384, S, 768, 384, EpiQ1{rs, rope, q1});
    launch_gemm(stream, z1 + 896, ODD_IN_P, w_uk, 256, S, 512, 256, EpiRowScaleBf16{rs, 1, k1, 512});
    launch_gemm(stream, w_uv, 256, z1 + 896, ODD_IN_P, 512, S, 256, EpiColScaleBf16{rs, 1, vt, S});
    hipLaunchKernelGGL(k_mla_attn, dim3(S, 8), dim3(256), 65536, stream, q1, k1, kr, vt, y1);
    launch_gemm(stream, y1, D, w_out1, D, S, D, D, EpiResid{out, out});
    hipLaunchKernelGGL(k_ln, dim3(S / 4), dim3(256), 0, stream, out, ln_mix_g + D, ln_mix_b + D, xb);
    hipLaunchKernelGGL(k_ffn_up, dim3(DFF / 256, S / 8), dim3(256), 0, stream, xb, w_up1, bias_up1, ffn_conv_w + (size_t)3 * DFF2, g);
    launch_gemm(stream, g, DFF, w_dn1, DFF, S, D, DFF, EpiResid{out, out});
    hipLaunchKernelGGL(k_ln, dim3(S / 4), dim3(256), 0, stream, out, ln_ffn_g + D, ln_ffn_b + D, xb);
}
```

```cpp
#include <hip/hip_runtime.h>
#include <cstdint>
#include <cstdio>

typedef unsigned short bf16_t;
typedef _Float16 f16_t;

#ifndef MK_SPLIT
#define MK_SPLIT 0
#endif

constexpr int S = 16384, D = 1024;
constexpr int EVEN_IN = 3656, EVEN_IN_P = 3840;
constexpr int ODD_IN = 1184, ODD_IN_P = 1280;
constexpr int DFF = 2816, DFF2 = 5632;
constexpr int TOPK = 256;
constexpr float DN_ALPHA = 1.41421356237309515f;
constexpr float LN_EPS = 1e-5f, RMS_EPS = 1e-6f;
constexpr float MLA_QSCALE = 0.14724444602590306f;
constexpr int NT = 512;

constexpr size_t MiB = 1u << 20;
constexpr size_t WS_CTL = 0, CTL_ZERO_BYTES = 1 * MiB;
constexpr size_t WS_MOD = 1 * MiB;
constexpr size_t WS_BIAS_IN0 = 1 * MiB + 64 * 1024;
constexpr size_t WS_BIAS_UP0 = 1 * MiB + 96 * 1024;
constexpr size_t WS_BIAS_IN1 = 1 * MiB + 128 * 1024;
constexpr size_t WS_BIAS_UP1 = 1 * MiB + 160 * 1024;
constexpr size_t WS_RS = 1 * MiB + 256 * 1024;
constexpr size_t WS_ROPE = 2 * MiB;
constexpr size_t WS_W_IN0 = 4 * MiB;
constexpr size_t WS_W_OUT0 = 12 * MiB;
constexpr size_t WS_W_UP0 = 14 * MiB;
constexpr size_t WS_W_DN0 = 25 * MiB;
constexpr size_t WS_W_IN1 = 31 * MiB;
constexpr size_t WS_W_POOL = 34 * MiB;
constexpr size_t WS_W_UQ = 35 * MiB;
constexpr size_t WS_W_UK = 36 * MiB;
constexpr size_t WS_W_UV = 36 * MiB + 512 * 1024;
constexpr size_t WS_W_OUT1 = 37 * MiB;
constexpr size_t WS_W_UP1 = 39 * MiB;
constexpr size_t WS_W_DN1 = 50 * MiB;
constexpr size_t WS_XB = 56 * MiB;
constexpr size_t WS_Q0 = 88 * MiB, WS_K0 = 104 * MiB, WS_V0 = 120 * MiB;
constexpr size_t WS_QI = 136 * MiB;
constexpr size_t WS_BG = 152 * MiB, WS_CG = 168 * MiB, WS_XC = 184 * MiB;
constexpr size_t WS_KI = 200 * MiB;
constexpr size_t WS_WI = 202 * MiB;
constexpr size_t WS_IDX = 203 * MiB;
constexpr size_t WS_Y0 = 212 * MiB;
constexpr size_t WS_G = 88 * MiB;
constexpr size_t WS_HU = 176 * MiB;
constexpr size_t WS_Z1 = 88 * MiB;
constexpr size_t WS_PL = 128 * MiB;
constexpr size_t WS_Q1 = 144 * MiB;
constexpr size_t WS_K1 = 168 * MiB;
constexpr size_t WS_KR = 184 * MiB;
constexpr size_t WS_VT = 186 * MiB;
constexpr size_t WS_Y1 = 202 * MiB;
constexpr size_t WS_END = 256 * MiB;

constexpr int CW_BAR = 4096;

constexpr int RING_BYTES = 131072;
constexpr int LDSCTL_OFF = RING_BYTES, MISC_OFF = LDSCTL_OFF + 320;
constexpr int LDS_BYTES = 147456;

#define GAS __attribute__((address_space(1)))
#define LAS __attribute__((address_space(3)))
typedef GAS unsigned gu32;
#define LDS_WAIT() asm volatile("s_waitcnt lgkmcnt(0)" ::: "memory")
__device__ __forceinline__ float bf2f(bf16_t h) { return __uint_as_float(((unsigned)h) << 16); }
__device__ __forceinline__ bf16_t f2bf(float f) { unsigned u = __float_as_uint(f); return (bf16_t)((u + 0x7fffu + ((u >> 16) & 1u)) >> 16); }
__device__ __forceinline__ unsigned pk2(float lo, float hi) { return (unsigned)f2bf(lo) | ((unsigned)f2bf(hi) << 16); }
__device__ __forceinline__ float bflo(unsigned w) { return __uint_as_float(w << 16); }
__device__ __forceinline__ float bfhi(unsigned w) { return __uint_as_float(w & 0xffff0000u); }
__device__ __forceinline__ float h2f_lo(unsigned w) { return (float)__builtin_bit_cast(_Float16, (unsigned short)(w & 0xffffu)); }
__device__ __forceinline__ float h2f_hi(unsigned w) { return (float)__builtin_bit_cast(_Float16, (unsigned short)(w >> 16)); }
__device__ __forceinline__ float wave_sum(float v) {
#pragma unroll
    for (int o = 1; o < 64; o <<= 1) v += __shfl_xor(v, o);
    return v;
}
__device__ __forceinline__ float wave_max(float v) {
#pragma unroll
    for (int o = 1; o < 64; o <<= 1) v = fmaxf(v, __shfl_xor(v, o));
    return v;
}
__device__ __forceinline__ float silu_f(float v) { return v / (1.f + __expf(-v)); }
__device__ __forceinline__ float dot8(const uint4 a, const uint4 b) {
    return bflo(a.x) * bflo(b.x) + bfhi(a.x) * bfhi(b.x) + bflo(a.y) * bflo(b.y) + bfhi(a.y) * bfhi(b.y)
         + bflo(a.z) * bflo(b.z) + bfhi(a.z) * bfhi(b.z) + bflo(a.w) * bflo(b.w) + bfhi(a.w) * bfhi(b.w);
}
template <class P> __device__ __forceinline__ float dot8q(P q, const uint4 u) {
    return q[0] * bflo(u.x) + q[1] * bfhi(u.x) + q[2] * bflo(u.y) + q[3] * bfhi(u.y) + q[4] * bflo(u.z) + q[5] * bfhi(u.z) + q[6] * bflo(u.w) + q[7] * bfhi(u.w);
}

__device__ __forceinline__ int tid_opaque() { int t = threadIdx.x; asm volatile("" : "+v"(t)); return t; }
template <class T> __device__ __forceinline__ LAS T* lptr(unsigned char* lds, int off) {
    unsigned b = (unsigned)(uintptr_t)((LAS unsigned char*)lds + off);
    asm volatile("" : "+s"(b));
    return (LAS T*)(uintptr_t)b;
}
__constant__ float c_inv_freq[16] = {1.0f, 0.5623413324356079f, 0.3162277638912201f, 0.17782793939113617f, 0.10000000149011612f, 0.05623413249850273f,
    0.03162277489900589f, 0.017782794311642647f, 0.009999999776482582f, 0.005623413249850273f, 0.003162277629598975f, 0.0017782794311642647f,
    0.0010000000474974513f, 0.000562341301701963f, 0.0003162277571391314f, 0.00017782794020604342f};

namespace pg8 {
#define PG8_LAS __attribute__((address_space(3)))
typedef unsigned short bf16_t;
typedef short bf16x8 __attribute__((ext_vector_type(8)));
typedef float f32x4 __attribute__((ext_vector_type(4)));
typedef unsigned u32x4 __attribute__((ext_vector_type(4)));
constexpr int BM = 256, BK = 64, HALF = 128, HTB = HALF * BK * 2  , STAGE_BYTES = 8 * HTB, NXCD = 8, WGM = 8;

__host__ __device__ __forceinline__ int lds_byte(int r, int c) { const int st = (r >> 4) * 2 + (c >> 5), rr = r & 15, cc = c & 31, ob = rr * 64 + cc * 2; return st * 1024 + (ob ^ (((ob >> 9) & 1) << 5)); }
__host__ __device__ __forceinline__ void stage_rc(int b, int& R, int& C) { const int st = b / 1024, sb = b % 1024, swz = sb ^ (((sb >> 9) & 1) << 5); R = (st >> 1) * 16 + swz / 64; C = (st & 1) * 32 + (swz % 64) / 2; }
__host__ __device__ __forceinline__ int perm32(int rho) { const int n = rho >> 4, i = rho & 15; return 8 * (i >> 2) + 4 * n + (i & 3); }

struct Unit { int pm, pn; };
struct Gemm { const bf16_t* A; const bf16_t* Bt; int M, N, K, lda, ldb; };

struct StaticOrder {
    int nM, nN, nwg, G, c;
    __host__ __device__ void init(int M, int N, int G_, int c_) { nM = M / BM; nN = N / BM; nwg = nM * nN; G = G_; c = c_; }
    __host__ __device__ bool next(int i, Unit& u) const {
        const long L = (long)i * G + c; if (L >= nwg) return false;
        int wgid = (int)L; { const int q = nwg / NXCD, r = nwg % NXCD, xcd = wgid % NXCD, off = wgid / NXCD; wgid = (xcd < r ? xcd * (q + 1) : r * (q + 1) + (xcd - r) * q) + off; }
        const int nig = WGM * nN, gid = wgid / nig, fm = gid * WGM, gsz = (nM - fm) < WGM ? (nM - fm) : WGM;
        u.pm = fm + ((wgid % nig) % gsz); u.pn = (wgid % nig) / gsz; return true;
    }
    __device__ __forceinline__ void a_ready(const Unit&) const {}
    __device__ __forceinline__ void done(const Unit&) const {}
};

__device__ __forceinline__ unsigned cvt_pk_bf16(float lo, float hi) { unsigned r; asm volatile("v_cvt_pk_bf16_f32 %0, %1, %2" : "=v"(r) : "v"(lo), "v"(hi)); return r; }
template <class Epi, class Sched, bool ALIGN_EPI = false, bool SP2 = false>
__device__ __forceinline__ void gemm_phase(PG8_LAS unsigned char* lds, const Gemm g, const Sched& S, const Epi& E) {
    int tid = threadIdx.x; asm volatile("" : "+v"(tid)); const int wid = __builtin_amdgcn_readfirstlane(tid >> 6), lane = tid & 63, wr = wid >> 2, wc = wid & 3, fr = lane & 15, fq = lane >> 4;
    const int K = g.K, nt = K / BK;
    unsigned voffA[2], voffB[2];
#pragma unroll
    for (int i = 0; i < 2; ++i) { int R, C; stage_rc(tid * 16 + i * 8192, R, C); const int Rb = Epi::PERM ? ((R & ~31) + perm32(R & 31)) : R;
        voffA[i] = (unsigned)(R * g.lda + C) * 2u; voffB[i] = (unsigned)(Rb * g.ldb + C) * 2u; }
    const size_t kstep = (size_t)(BK * 2);
    const size_t hstepA = (size_t)HALF * g.lda * 2, hstepB = (size_t)HALF * g.ldb * 2;
    const size_t tstepA = 2 * hstepA, tstepB = 2 * hstepB;
    const unsigned ldsw = (unsigned)wid * 1024u;
    const int aoff = lds_byte(wr * 64 + fr, fq * 8), boff = lds_byte(wc * 32 + fr, fq * 8);
#define PG8_SA(b, h) (((b) * 2 + (h)) * HTB)
#define PG8_SB(b, h) ((4 + (b) * 2 + (h)) * HTB)
#define PG8_STAGE(bufoff, gbase, voff) do { _Pragma("unroll") for (int _i = 0; _i < 2; ++_i) \
        __builtin_amdgcn_global_load_lds((const unsigned*)((const char*)(gbase) + (voff)[_i]), (PG8_LAS unsigned*)(lds + (bufoff) + ldsw + _i * 8192), 16, 0, 0); } while (0)
#define PG8_LDA(dst, b, h) do { _Pragma("unroll") for (int m = 0; m < 4; ++m) _Pragma("unroll") for (int k = 0; k < 2; ++k) dst[m][k] = *(const PG8_LAS bf16x8*)(lds + PG8_SA(b, h) + aoff + m * 2048 + k * 1024); } while (0)
#define PG8_LDB(dst, b, h) do { _Pragma("unroll") for (int n = 0; n < 2; ++n) _Pragma("unroll") for (int k = 0; k < 2; ++k) dst[n][k] = *(const PG8_LAS bf16x8*)(lds + PG8_SB(b, h) + boff + n * 2048 + k * 1024); } while (0)
#define PG8_MMA(ai, bj, At, Bt) do { __builtin_amdgcn_s_setprio(1); _Pragma("unroll") for (int m = 0; m < 4; ++m) _Pragma("unroll") for (int n = 0; n < 2; ++n) _Pragma("unroll") for (int k = 0; k < 2; ++k) \
        acc[ai][bj][m][n] = __builtin_amdgcn_mfma_f32_16x16x32_bf16(Bt[n][k], At[m][k], acc[ai][bj][m][n], 0, 0, 0); __builtin_amdgcn_s_setprio(0); } while (0)
#define PG8_WAIT_V(n) asm volatile("s_waitcnt vmcnt(" #n ")" ::: "memory")
#define PG8_WAIT_L(n) asm volatile("s_waitcnt lgkmcnt(" #n ")" ::: "memory")
#define PG8_BAR __builtin_amdgcn_s_barrier()
#define PG8_SCHED __builtin_amdgcn_sched_barrier(0)
    Unit cur, nxt; int ui = 0;
    if (!S.next(0, cur)) return;
    f32x4 acc[2][2][4][2];
#pragma unroll
    for (int a = 0; a < 2; ++a)
#pragma unroll
        for (int b = 0; b < 2; ++b)
#pragma unroll
            for (int m = 0; m < 4; ++m)
#pragma unroll
                for (int n = 0; n < 2; ++n) acc[a][b][m][n] = (f32x4){0.f, 0.f, 0.f, 0.f};
    bf16x8 At[4][2], B0[2][2], B1[2][2];
    const char* cA = (const char*)g.A + (size_t)cur.pm * tstepA; const char* cB = (const char*)g.Bt + (size_t)cur.pn * tstepB;
    S.a_ready(cur);
    if constexpr (SP2) {
        PG8_STAGE(PG8_SB(0, 0), cB, voffB); PG8_STAGE(PG8_SB(0, 1), cB + hstepB, voffB); PG8_STAGE(PG8_SA(0, 0), cA, voffA); PG8_STAGE(PG8_SA(0, 1), cA + hstepA, voffA);
        if (wr == 1) PG8_BAR;
        PG8_WAIT_V(2); PG8_BAR;
        PG8_STAGE(PG8_SB(1, 0), cB + kstep, voffB); PG8_STAGE(PG8_SA(1, 0), cA + kstep, voffA); PG8_STAGE(PG8_SB(1, 1), cB + hstepB + kstep, voffB);
        PG8_WAIT_V(6); PG8_BAR;
    } else {
        PG8_STAGE(PG8_SB(0, 0), cB, voffB); PG8_STAGE(PG8_SA(0, 0), cA, voffA); PG8_STAGE(PG8_SB(0, 1), cB + hstepB, voffB); PG8_STAGE(PG8_SA(0, 1), cA + hstepA, voffA);
        if (wr == 1) PG8_BAR;
        PG8_WAIT_V(4); PG8_BAR;
        PG8_STAGE(PG8_SB(1, 0), cB + kstep, voffB); PG8_STAGE(PG8_SA(1, 0), cA + kstep, voffA); PG8_STAGE(PG8_SB(1, 1), cB + hstepB + kstep, voffB);
        PG8_WAIT_V(6); PG8_BAR;
    }
    for (;;) {
        const bool has_next = S.next(ui + 1, nxt);
        const char* nA = has_next ? (const char*)g.A + (size_t)nxt.pm * tstepA : cA; const char* nB = has_next ? (const char*)g.Bt + (size_t)nxt.pn * tstepB : cB;
        for (int t = 0; t < nt; t += 2) {
            const bool last = (t == nt - 2);
            const char* a1 = cA + (size_t)(t + 1) * kstep;
            const char* a2 = last ? nA : cA + (size_t)(t + 2) * kstep; const char* b2 = last ? nB : cB + (size_t)(t + 2) * kstep;
            const char* a3 = a2 + kstep; const char* b3 = b2 + kstep;
            if (last && has_next) S.a_ready(nxt);
            if constexpr (SP2) {
            PG8_LDB(B0, 0, 0); PG8_LDB(B1, 0, 1); PG8_SCHED; PG8_LDA(At, 0, 0); PG8_STAGE(PG8_SA(1, 1), a1 + hstepA, voffA);
            PG8_WAIT_V(8); PG8_WAIT_L(0); PG8_BAR; PG8_MMA(0, 0, At, B0); PG8_MMA(0, 1, At, B1); PG8_BAR; PG8_SCHED;
            PG8_LDA(At, 0, 1); PG8_STAGE(PG8_SB(0, 0), b2, voffB); PG8_STAGE(PG8_SB(0, 1), b2 + hstepB, voffB); PG8_STAGE(PG8_SA(0, 0), a2, voffA);
            PG8_WAIT_V(8); PG8_WAIT_L(0); PG8_BAR; PG8_MMA(1, 0, At, B0); PG8_MMA(1, 1, At, B1); PG8_BAR; PG8_SCHED;
            PG8_LDB(B0, 1, 0); PG8_LDB(B1, 1, 1); PG8_SCHED; PG8_LDA(At, 1, 0); PG8_STAGE(PG8_SA(0, 1), a2 + hstepA, voffA);
            PG8_WAIT_V(8); PG8_WAIT_L(0); PG8_BAR; PG8_MMA(0, 0, At, B0); PG8_MMA(0, 1, At, B1); PG8_BAR; PG8_SCHED;
            PG8_LDA(At, 1, 1); PG8_STAGE(PG8_SB(1, 0), b3, voffB); PG8_STAGE(PG8_SB(1, 1), b3 + hstepB, voffB); PG8_STAGE(PG8_SA(1, 0), a3, voffA);
            PG8_WAIT_V(8); PG8_WAIT_L(0); PG8_BAR; PG8_MMA(1, 0, At, B0); PG8_MMA(1, 1, At, B1); PG8_BAR; PG8_SCHED;
            } else {
            PG8_LDB(B0, 0, 0); PG8_SCHED; PG8_LDA(At, 0, 0); PG8_STAGE(PG8_SA(1, 1), a1 + hstepA, voffA);
            PG8_WAIT_L(8); PG8_BAR; PG8_WAIT_L(0); PG8_MMA(0, 0, At, B0); PG8_BAR; PG8_SCHED;
            PG8_LDB(B1, 0, 1); PG8_STAGE(PG8_SB(0, 0), b2, voffB);
            PG8_BAR; PG8_WAIT_L(0); PG8_MMA(0, 1, At, B1); PG8_BAR;
            PG8_LDA(At, 0, 1); PG8_STAGE(PG8_SA(0, 0), a2, voffA);
            PG8_BAR; PG8_WAIT_L(0); PG8_MMA(1, 0, At, B0); PG8_BAR; PG8_SCHED;
            PG8_STAGE(PG8_SB(0, 1), b2 + hstepB, voffB);
            PG8_WAIT_V(6); PG8_BAR; PG8_MMA(1, 1, At, B1); PG8_BAR;
            PG8_LDB(B0, 1, 0); PG8_SCHED; PG8_LDA(At, 1, 0); PG8_STAGE(PG8_SA(0, 1), a2 + hstepA, voffA);
            PG8_WAIT_L(8); PG8_BAR; PG8_WAIT_L(0); PG8_MMA(0, 0, At, B0); PG8_BAR; PG8_SCHED;
            PG8_LDB(B1, 1, 1); PG8_STAGE(PG8_SB(1, 0), b3, voffB);
            PG8_BAR; PG8_WAIT_L(0); PG8_MMA(0, 1, At, B1); PG8_BAR;
            PG8_LDA(At, 1, 1); PG8_STAGE(PG8_SA(1, 0), a3, voffA);
            PG8_BAR; PG8_WAIT_L(0); PG8_MMA(1, 0, At, B0); PG8_BAR; PG8_SCHED;
            PG8_STAGE(PG8_SB(1, 1), b3 + hstepB, voffB);
            PG8_WAIT_V(6); PG8_BAR; PG8_MMA(1, 1, At, B1); PG8_BAR;
            }
        }
        if constexpr (ALIGN_EPI) { if (wr == 0) PG8_BAR; }
        if constexpr (!Epi::AFTER_DRAIN) { E(acc, cur, wr, wc, fr, fq); S.done(cur); }
        if (!has_next) break;
#pragma unroll
        for (int a = 0; a < 2; ++a)
#pragma unroll
            for (int b = 0; b < 2; ++b)
#pragma unroll
                for (int m = 0; m < 4; ++m)
#pragma unroll
                    for (int n = 0; n < 2; ++n) acc[a][b][m][n] = (f32x4){0.f, 0.f, 0.f, 0.f};
        cur = nxt; cA = nA; cB = nB; ++ui;
        if constexpr (ALIGN_EPI) { if (wr == 1) PG8_BAR; }
    }
    PG8_WAIT_V(0);
    if constexpr (!ALIGN_EPI) { if (wr == 0) PG8_BAR; }
    PG8_BAR;
    if constexpr (Epi::AFTER_DRAIN) { E.fused(acc, cur, wr, wc, fr, fq, lds, wid, lane); S.done(cur); }
#undef PG8_SA
#undef PG8_SB
#undef PG8_STAGE
#undef PG8_LDA
#undef PG8_LDB
#undef PG8_MMA
#undef PG8_WAIT_V
#undef PG8_WAIT_L
#undef PG8_BAR
#undef PG8_SCHED
}
}


#define XB_TMO      128
#define XB_XCNT(j)  (256  + 64 * (j))
#define XB_XSUB(j)  (1280 + 64 * (j))
#define XB_XGEN(j)  (2304 + 64 * (j))
#define XB_TOP      3328
#define XB_TOPGEN   3392
#define XCD_BAR_WORDS 3456
#define XB_SPIN_CAP (1u << 18)

__device__ __forceinline__ unsigned xb_ld(unsigned* p)              { return __hip_atomic_load(p, __ATOMIC_RELAXED, __HIP_MEMORY_SCOPE_AGENT); }
__device__ __forceinline__ unsigned xb_add(unsigned* p, unsigned v) { return __hip_atomic_fetch_add(p, v, __ATOMIC_RELAXED, __HIP_MEMORY_SCOPE_AGENT); }
__device__ __forceinline__ unsigned xb_xcc_id() { return (unsigned)__builtin_amdgcn_s_getreg((3 << 11) | 20) & 0xFu; }
#define XB_SPIN(cond, bar) do { unsigned _sp = 0; while (cond) { __builtin_amdgcn_s_sleep(1); \
    if ((++_sp & 255u) == 0u) { if (xb_ld(&(bar)[XB_TMO])) break; if (_sp > XB_SPIN_CAP) { atomicAdd(&(bar)[XB_TMO], 1u); break; } } } } while (0)

struct XcdBarrier {
    unsigned* bar; unsigned x;
    volatile LAS unsigned* st;
};

__device__ __forceinline__ XcdBarrier xcd_barrier_post(unsigned* bar, volatile LAS unsigned* st) {
    XcdBarrier b; b.bar = bar; b.x = xb_xcc_id(); b.st = st;
    if (threadIdx.x == 0) (void)xb_add(&bar[XB_XCNT(b.x)], 1u);
    return b;
}
__device__ __forceinline__ void xcd_barrier_complete(unsigned* bar, unsigned x, unsigned& nloc, unsigned& nx) {
    const unsigned G = gridDim.x * gridDim.y * gridDim.z;
    unsigned sum, cnt, mine, sp = 0u;
    for (;;) {
        sum = 0u; cnt = 0u; mine = 0u;
#pragma unroll
        for (unsigned j = 0; j < 16; ++j) { const unsigned c = xb_ld(&bar[XB_XCNT(j)]); sum += c; cnt += (c > 0u) ? 1u : 0u; mine = (j == x) ? c : mine; }
        if (sum == G) break;
        __builtin_amdgcn_s_sleep(1);
        if ((++sp & 255u) == 0u) { if (xb_ld(&bar[XB_TMO])) break; if (sp > XB_SPIN_CAP) { atomicAdd(&bar[XB_TMO], 1u); break; } }
    }
    nloc = mine > 0u ? mine : 1u; nx = cnt > 0u ? cnt : 1u;
}

__device__ __forceinline__ void xcd_barrier(const XcdBarrier& b) {
    asm volatile("s_waitcnt vmcnt(0)" ::: "memory");
    __syncthreads();
    if (threadIdx.x == 0) {
        unsigned* bar = b.bar;
        __builtin_amdgcn_s_waitcnt(0);
        unsigned nloc = b.st[0], nx = b.st[1];
        if (nloc == 0u) { xcd_barrier_complete(bar, b.x, nloc, nx); b.st[0] = nloc; b.st[1] = nx; }
        const unsigned old = xb_add(&bar[XB_XSUB(b.x)], 1u);
        const unsigned gen = old / nloc;
        if (old + 1u == (gen + 1u) * nloc) {
            __builtin_amdgcn_fence(__ATOMIC_RELEASE, "agent");
            asm volatile("s_waitcnt vmcnt(0)" ::: "memory");
            const unsigned og = xb_add(&bar[XB_TOP], 1u);
            const unsigned tg = og / nx;
            if (og + 1u == (tg + 1u) * nx) xb_add(&bar[XB_TOPGEN], 1u);
            else XB_SPIN(xb_ld(&bar[XB_TOPGEN]) == tg, bar);
            __builtin_amdgcn_fence(__ATOMIC_ACQUIRE, "agent");
            xb_add(&bar[XB_XGEN(b.x)], 1u);
            asm volatile("s_waitcnt vmcnt(0)" ::: "memory");
        } else {
            XB_SPIN(xb_ld(&bar[XB_XGEN(b.x)]) == gen, bar);
            __builtin_amdgcn_fence(__ATOMIC_ACQUIRE, "agent");
            asm volatile("s_waitcnt vmcnt(0)" ::: "memory");
        }
    }
    __syncthreads();
}


struct Args {
    const float *x, *c, *ada_w, *ada_b, *ln_mix_g, *ln_mix_b, *ln_ffn_g, *ln_ffn_b, *ev_w_in, *ev_conv_w, *ev_w_out, *od_w_in, *pool_w, *pool_scale,
                *q_norm_g, *w_uq, *kv_norm_g, *w_ukv, *od_w_out, *ffn_w_up, *ffn_conv_w, *ffn_w_down;
    float* out; unsigned char* ws; int ph_lo, ph_hi;
};

#define AS4 __attribute__((address_space(4)))
typedef const AS4 Args KArgs;
__device__ __forceinline__ KArgs& kargs() { unsigned z = 0; asm volatile("" : "+s"(z)); return *(KArgs*)((const AS4 char*)__builtin_amdgcn_kernarg_segment_ptr() + z); }

__device__ __forceinline__ void st_bf16x4(bf16_t* p, float a, float b, float c, float d) { uint2 w; w.x = pk2(a, b); w.y = pk2(c, d); *(uint2*)p = w; }
struct EpiIn0 {
    const float* bias; bf16_t *q, *k, *v, *bg, *cg, *xc; f16_t *qi, *ki; float* wi;
    __device__ __forceinline__ void store4(int r, int c, float a, float b, float cc, float d) const {
        if (c >= EVEN_IN) return;
        const float4 bv = *(const float4*)(bias + c); a += bv.x; b += bv.y; cc += bv.z; d += bv.w;
        if (c < 512) { st_bf16x4(q + (size_t)r * 512 + c, a * 0.125f, b * 0.125f, cc * 0.125f, d * 0.125f); return; }
        if (c < 1024) { st_bf16x4(k + (size_t)r * 512 + (c - 512), a, b, cc, d); return; }
        if (c < 1536) { st_bf16x4(v + (size_t)r * 512 + (c - 1024), a, b, cc, d); return; }
        if (c < 2048) { f16_t* p = qi + (size_t)r * 512 + (c - 1536); p[0] = (f16_t)a; p[1] = (f16_t)b; p[2] = (f16_t)cc; p[3] = (f16_t)d; return; }
        if (c < 2112) { f16_t* p = ki + (size_t)r * 64 + (c - 2048); p[0] = (f16_t)a; p[1] = (f16_t)b; p[2] = (f16_t)cc; p[3] = (f16_t)d; return; }
        if (c < 2120) { *(float4*)(wi + (size_t)r * 8 + (c - 2112)) = make_float4(a, b, cc, d); return; }
        if (c < 2632) { st_bf16x4(bg + (size_t)r * 512 + (c - 2120), a, b, cc, d); return; }
        if (c < 3144) { st_bf16x4(cg + (size_t)r * 512 + (c - 2632), a, b, cc, d); return; }
        st_bf16x4(xc + (size_t)r * 512 + (c - 3144), a, b, cc, d);
    }
};
struct EpiResid {
    const float* res; float* pre;
    __device__ __forceinline__ void store4(int r, int c, float a, float b, float cc, float d) const {
        const float4 x = *(const float4*)(res + (size_t)r * D + c);
        *(float4*)(pre + (size_t)r * D + c) = make_float4(DN_ALPHA * x.x + a, DN_ALPHA * x.y + b, DN_ALPHA * x.z + cc, DN_ALPHA * x.w + d);
    }
};
struct EpiBiasBf16 {
    const float* bias; bf16_t* out; int ldc;
    __device__ __forceinline__ void store4(int r, int c, float a, float b, float cc, float d) const {
        const float4 bv = *(const float4*)(bias + c);
        st_bf16x4(out + (size_t)r * ldc + c, a + bv.x, b + bv.y, cc + bv.z, d + bv.w);
    }
};
struct EpiPlainBf16 {
    bf16_t* out; int ldc;
    __device__ __forceinline__ void store4(int r, int c, float a, float b, float cc, float d) const { st_bf16x4(out + (size_t)r * ldc + c, a, b, cc, d); }
};
struct EpiRowScaleBf16 {
    const float* rs; int which; bf16_t* out; int ldc;
    __device__ __forceinline__ void store4(int r, int c, float a, float b, float cc, float d) const {
        const float s = rs[(size_t)r * 2 + which]; st_bf16x4(out + (size_t)r * ldc + c, a * s, b * s, cc * s, d * s);
    }
};
struct EpiColScaleBf16 {
    const float* rs; int which; bf16_t* out; int ldc;
    __device__ __forceinline__ void store4(int r, int c, float a, float b, float cc, float d) const {
        st_bf16x4(out + (size_t)r * ldc + c, a * rs[(size_t)c * 2 + which], b * rs[(size_t)(c + 1) * 2 + which], cc * rs[(size_t)(c + 2) * 2 + which], d * rs[(size_t)(c + 3) * 2 + which]);
    }
};
struct EpiQ1 {
    const float* rs; const float* rope; bf16_t* out;
    __device__ __forceinline__ void store4(int r, int c, float a, float b, float cc, float d) const {
        const float s = rs[(size_t)r * 2]; a *= s; b *= s; cc *= s; d *= s;
        const int e = c % 96;
        if (e >= 64) {
            const int i = (e - 64) >> 1;
            const float c0 = rope[(size_t)r * 16 + i], s0 = rope[(size_t)S * 16 + (size_t)r * 16 + i];
            const float c1 = rope[(size_t)r * 16 + i + 1], s1 = rope[(size_t)S * 16 + (size_t)r * 16 + i + 1];
            const float a2 = a * c0 - b * s0, b2 = b * c0 + a * s0, c2 = cc * c1 - d * s1, d2 = d * c1 + cc * s1;
            a = a2; b = b2; cc = c2; d = d2;
        }
        st_bf16x4(out + (size_t)r * 768 + c, a, b, cc, d);
    }
};
template <class F> struct EpiFn {
    static constexpr bool PERM = true, AFTER_DRAIN = false;
    F f;
    __device__ __forceinline__ void operator()(const pg8::f32x4 (&acc)[2][2][4][2], const pg8::Unit& u, int wr, int wc, int fr, int fq) const {
        const int row0 = u.pm * 256 + wr * 64 + fr, col0 = u.pn * 256 + wc * 32 + 8 * fq;
#pragma unroll
        for (int ai = 0; ai < 2; ++ai)
#pragma unroll
            for (int m = 0; m < 4; ++m)
#pragma unroll
                for (int bj = 0; bj < 2; ++bj)
#pragma unroll
                    for (int n = 0; n < 2; ++n) { const pg8::f32x4 v = acc[ai][bj][m][n]; f.store4(row0 + ai * 128 + m * 16, col0 + bj * 128 + 4 * n, v[0], v[1], v[2], v[3]);
                                                  asm volatile("" ::: "memory"); }
    }
};
template <class F>
__device__ __forceinline__ void run_gemm(unsigned char* lds, const bf16_t* A, int lda, const bf16_t* Bt, int ldb, int M, int N, int K, const F& f, int nb, int bid) {
    asm volatile("" : "+s"(K), "+s"(lda), "+s"(ldb));
    pg8::Gemm g{A, Bt, M, N, K, lda, ldb}; pg8::StaticOrder So; So.init(M, N, nb, bid);
    EpiFn<F> E{f};
    pg8::gemm_phase<EpiFn<F>, pg8::StaticOrder, true, true>((PG8_LAS unsigned char*)lds, g, So, E);
}

__device__ __forceinline__ void ph_mod(KArgs& a, unsigned char* lds, int bid, int nb) {
    float* mod = (float*)(a.ws + WS_MOD);
    LAS float* red = lptr<float>(lds, 0);
    const int tid = tid_opaque(), lane = tid & 63, wave = tid >> 6;
    for (int it = bid; it < 192; it += nb) {
        const int n = it * 64 + lane, l = n / 6144, nn = n % 6144;
        const float* w = a.ada_w + (size_t)l * 1024 * 6144 + nn;
        float acc = 0.f;
        for (int k = wave * 128; k < wave * 128 + 128; ++k) acc += silu_f(a.c[k]) * w[(size_t)k * 6144];
        red[wave * 64 + lane] = acc;
        __syncthreads();
        if (wave == 0) { float s = 0.f;
#pragma unroll
            for (int q = 0; q < 8; ++q) s += red[q * 64 + lane];
            mod[n] = s + a.ada_b[n]; }
        __syncthreads();
    }
    float* rope = (float*)(a.ws + WS_ROPE);
    for (int gid = bid * NT + tid; gid < S * 16; gid += nb * NT) {
        const int t = gid >> 4, i = gid & 15;
        const float ang = (float)t * c_inv_freq[i];
        double rev = (double)ang * 0.15915494309189535;
        rev -= rint(rev);
        const float f = (float)rev;
        rope[gid] = __builtin_amdgcn_cosf(f);
        rope[S * 16 + gid] = __builtin_amdgcn_sinf(f);
    }
}
__device__ __forceinline__ int src_col(int mode, int n, int Nsrc) {
    if (mode == 0) return n < Nsrc ? n : -1;
    if (mode == 1) { const int tile = n >> 8, i = n & 255; return i < 128 ? tile * 128 + i : DFF + tile * 128 + (i - 128); }
    if (mode == 2) { const int h = n / 96, e = n % 96; if (e < 64) return h * 96 + e; const int i = (e - 64) >> 1; return h * 96 + 64 + ((e & 1) ? 16 + i : i); }
    if (mode == 3) { const int h = n >> 6, d = n & 63; return h * 128 + d; }
    { const int h = n >> 6, d = n & 63; return h * 128 + 64 + d; }
}
__device__ __forceinline__ void prep_item(const float* W, int K, int Nsrc, int Npad, int mode, const float* rs1p, const float* rs, const float* cs1p, float cst, bf16_t* dst,
                                          LAS float* scr, int item, int lane) {
    const int nblk = Npad / 32, kb = item / nblk, nbk = item % nblk, k0 = kb * 64, n0 = nbk * 32, nl = lane & 31;
    const int sn = src_col(mode, n0 + nl, Nsrc);
    float cs = cst; if (sn >= 0 && cs1p) cs *= 1.f + cs1p[sn];
#pragma unroll 8
    for (int i = 0; i < 32; ++i) {
        const int kk = 2 * i + (lane >> 5), k = k0 + kk;
        float v = 0.f;
        if (sn >= 0) { v = W[(size_t)k * Nsrc + sn] * cs; if (rs1p) v *= 1.f + rs1p[k]; if (rs) v *= rs[k]; }
        scr[kk * 33 + nl] = v;
    }
    LDS_WAIT();
    const int c = lane & 7;
#pragma unroll
    for (int j = 0; j < 4; ++j) {
        const int n = (lane >> 3) + 8 * j; const LAS float* s = scr + (8 * c) * 33 + n;
        uint4 o; o.x = pk2(s[0 * 33], s[1 * 33]); o.y = pk2(s[2 * 33], s[3 * 33]); o.z = pk2(s[4 * 33], s[5 * 33]); o.w = pk2(s[6 * 33], s[7 * 33]);
        *(uint4*)(dst + (size_t)(n0 + n) * K + k0 + 8 * c) = o;
    }
    LDS_WAIT();
}
__device__ __forceinline__ void bias_item(const float* W, int K, int Nsrc, int mode, const float* shift, float* bias, LAS float* red, int item) {
    const int tid = tid_opaque(), lane = tid & 63, wave = tid >> 6;
    const int n = item * 64 + lane, sn = src_col(mode, n, Nsrc), ks = K / 8;
    float acc = 0.f;
    if (sn >= 0) for (int k = wave * ks; k < wave * ks + ks; ++k) acc += shift[k] * W[(size_t)k * Nsrc + sn];
    red[wave * 64 + lane] = acc;
    __syncthreads();
    if (wave == 0) { float s = 0.f;
#pragma unroll
        for (int q = 0; q < 8; ++q) s += red[q * 64 + lane];
        bias[n] = s; }
    __syncthreads();
}
__device__ __forceinline__ void ph_prep(KArgs& a, unsigned char* lds, int bid, int nb) {
    const int tid = tid_opaque(), lane = tid & 63, wave = tid >> 6;
    unsigned char* ws = a.ws;
    const float* m0 = (const float*)(ws + WS_MOD); const float* m1 = m0 + 6144;
    {
        LAS float* red = lptr<float>(lds, 0);
        for (int it = bid; it < 256; it += nb) {
            int r = it;
            if (r < 60) { bias_item(a.ev_w_in, 1024, EVEN_IN, 0, m0, (float*)(ws + WS_BIAS_IN0), red, r); continue; } r -= 60;
            if (r < 88) { bias_item(a.ffn_w_up, 1024, DFF2, 1, m0 + 3072, (float*)(ws + WS_BIAS_UP0), red, r); continue; } r -= 88;
            if (r < 20) { bias_item(a.od_w_in, 1024, ODD_IN, 0, m1, (float*)(ws + WS_BIAS_IN1), red, r); continue; } r -= 20;
            bias_item(a.ffn_w_up + (size_t)1024 * DFF2, 1024, DFF2, 1, m1 + 3072, (float*)(ws + WS_BIAS_UP1), red, r);
        }
    }
    {
        LAS float* scr = lptr<float>(lds, 4096) + wave * 2176;
        const int gw = bid * 8 + wave, NGW = nb * 8;
        constexpr int I_IN0 = 16 * (EVEN_IN_P / 32), I_SQ = 16 * 32, I_UP = 16 * (DFF2 / 32), I_DN = 44 * 32, I_IN1 = 16 * (ODD_IN_P / 32), I_UQ = 6 * 24, I_UKV = 4 * 16;
        constexpr int NITEMS = I_IN0 + I_SQ + I_UP + I_DN + I_IN1 + I_UQ + 2 * I_UKV + I_SQ + I_UP + I_DN;
        for (int it = gw; it < NITEMS; it += NGW) {
            int r = it;
            if (r < I_IN0) { prep_item(a.ev_w_in, 1024, EVEN_IN, EVEN_IN_P, 0, m0 + 1024, nullptr, nullptr, 1.f, (bf16_t*)(ws + WS_W_IN0), scr, r, lane); continue; } r -= I_IN0;
            if (r < I_SQ) { prep_item(a.ev_w_out, 1024, 1024, 1024, 0, nullptr, nullptr, m0 + 2048, 1.f, (bf16_t*)(ws + WS_W_OUT0), scr, r, lane); continue; } r -= I_SQ;
            if (r < I_UP) { prep_item(a.ffn_w_up, 1024, DFF2, DFF2, 1, m0 + 4096, nullptr, nullptr, 1.f, (bf16_t*)(ws + WS_W_UP0), scr, r, lane); continue; } r -= I_UP;
            if (r < I_DN) { prep_item(a.ffn_w_down, DFF, 1024, 1024, 0, nullptr, nullptr, m0 + 5120, 1.f, (bf16_t*)(ws + WS_W_DN0), scr, r, lane); continue; } r -= I_DN;
            if (r < I_IN1) { prep_item(a.od_w_in, 1024, ODD_IN, ODD_IN_P, 0, m1 + 1024, nullptr, nullptr, 1.f, (bf16_t*)(ws + WS_W_IN1), scr, r, lane); continue; } r -= I_IN1;
            if (r < I_UQ) { prep_item(a.w_uq, 384, 768, 768, 2, nullptr, a.q_norm_g, nullptr, MLA_QSCALE, (bf16_t*)(ws + WS_W_UQ), scr, r, lane); continue; } r -= I_UQ;
            if (r < I_UKV) { prep_item(a.w_ukv, 256, 1024, 512, 3, nullptr, a.kv_norm_g, nullptr, 1.f, (bf16_t*)(ws + WS_W_UK), scr, r, lane); continue; } r -= I_UKV;
            if (r < I_UKV) { prep_item(a.w_ukv, 256, 1024, 512, 4, nullptr, a.kv_norm_g, nullptr, 1.f, (bf16_t*)(ws + WS_W_UV), scr, r, lane); continue; } r -= I_UKV;
            if (r < I_SQ) { prep_item(a.od_w_out, 1024, 1024, 1024, 0, nullptr, nullptr, m1 + 2048, 1.f, (bf16_t*)(ws + WS_W_OUT1), scr, r, lane); continue; } r -= I_SQ;
            if (r < I_UP) { prep_item(a.ffn_w_up + (size_t)1024 * DFF2, 1024, DFF2, DFF2, 1, m1 + 4096, nullptr, nullptr, 1.f, (bf16_t*)(ws + WS_W_UP1), scr, r, lane); continue; } r -= I_UP;
            prep_item(a.ffn_w_down + (size_t)DFF * 1024, DFF, 1024, 1024, 0, nullptr, nullptr, m1 + 5120, 1.f, (bf16_t*)(ws + WS_W_DN1), scr, r, lane);
        }
    }
    {
        bf16_t* dst = (bf16_t*)(ws + WS_W_POOL);
        for (int gid = bid * NT + tid; gid < 512 * 512; gid += nb * NT) {
            const int n = gid >> 9, k = gid & 511, g = n >> 7, d = n & 127;
            float v = 0.f;
            if ((k >> 7) == g) v = a.pool_w[((size_t)g * 128 + (k & 127)) * 128 + d] * a.pool_scale[n];
            dst[gid] = f2bf(v);
        }
    }
    {
        bf16_t* xb = (bf16_t*)(ws + WS_XB);
        for (int gid = bid * NT + tid; gid < S * D / 4; gid += nb * NT) {
            const float4 v = ((const float4*)a.x)[gid];
            st_bf16x4(xb + (size_t)gid * 4, v.x, v.y, v.z, v.w);
        }
    }
}
__device__ __forceinline__ void ph_ln(float* pre, const float* g, const float* b, bf16_t* xb, int bid, int nb) {
    const int lane = tid_opaque() & 63, wave = tid_opaque() >> 6;
    for (int row = bid * 8 + wave; row < S; row += nb * 8) {
        float4* xr = (float4*)(pre + (size_t)row * D) + lane;
        float4 v[4]; float s = 0.f;
#pragma unroll
        for (int j = 0; j < 4; ++j) { v[j] = xr[64 * j]; s += (v[j].x + v[j].y) + (v[j].z + v[j].w); }
        const float mean = wave_sum(s) * (1.f / D); float s2 = 0.f;
#pragma unroll
        for (int j = 0; j < 4; ++j) { v[j].x -= mean; v[j].y -= mean; v[j].z -= mean; v[j].w -= mean; s2 += (v[j].x * v[j].x + v[j].y * v[j].y) + (v[j].z * v[j].z + v[j].w * v[j].w); }
        const float rstd = 1.f / sqrtf(wave_sum(s2) * (1.f / D) + LN_EPS);
#pragma unroll
        for (int j = 0; j < 4; ++j) {
            const float4 gg = ((const float4*)g)[64 * j + lane], bb = ((const float4*)b)[64 * j + lane];
            float4 o; o.x = v[j].x * rstd * gg.x + bb.x; o.y = v[j].y * rstd * gg.y + bb.y; o.z = v[j].z * rstd * gg.z + bb.z; o.w = v[j].w * rstd * gg.w + bb.w;
            xr[64 * j] = o;
            st_bf16x4(xb + (size_t)row * D + (64 * j + lane) * 4, o.x, o.y, o.z, o.w);
        }
    }
}
__device__ __forceinline__ void ph_shortconv(KArgs& a, int bid, int nb) {
    const bf16_t* bg = (const bf16_t*)(a.ws + WS_BG); const bf16_t* cg = (const bf16_t*)(a.ws + WS_CG); const bf16_t* xc = (const bf16_t*)(a.ws + WS_XC);
    bf16_t* y = (bf16_t*)(a.ws + WS_Y0);
    for (int gid = bid * NT + tid_opaque(); gid < S * 64; gid += nb * NT) {
        const int t = gid >> 6, c0 = (gid & 63) * 8;
        float acc[8];
#pragma unroll
        for (int e = 0; e < 8; ++e) acc[e] = 0.f;
#pragma unroll
        for (int kk = 0; kk < 3; ++kk) {
            const int tt = t - 2 + kk;
            if (tt >= 0) {
                const uint4 cgv = *(const uint4*)(cg + (size_t)tt * 512 + c0), xv = *(const uint4*)(xc + (size_t)tt * 512 + c0);
                const float4 w0 = *(const float4*)(a.ev_conv_w + kk * 512 + c0), w1 = *(const float4*)(a.ev_conv_w + kk * 512 + c0 + 4);
                acc[0] += w0.x * bflo(cgv.x) * bflo(xv.x); acc[1] += w0.y * bfhi(cgv.x) * bfhi(xv.x);
                acc[2] += w0.z * bflo(cgv.y) * bflo(xv.y); acc[3] += w0.w * bfhi(cgv.y) * bfhi(xv.y);
                acc[4] += w1.x * bflo(cgv.z) * bflo(xv.z); acc[5] += w1.y * bfhi(cgv.z) * bfhi(xv.z);
                acc[6] += w1.z * bflo(cgv.w) * bflo(xv.w); acc[7] += w1.w * bfhi(cgv.w) * bfhi(xv.w);
            }
        }
        const uint4 b = *(const uint4*)(bg + (size_t)t * 512 + c0);
        uint4 o; o.x = pk2(bflo(b.x) * acc[0], bfhi(b.x) * acc[1]); o.y = pk2(bflo(b.y) * acc[2], bfhi(b.y) * acc[3]);
        o.z = pk2(bflo(b.z) * acc[4], bfhi(b.z) * acc[5]); o.w = pk2(bflo(b.w) * acc[6], bfhi(b.w) * acc[7]);
        *(uint4*)(y + (size_t)t * 1024 + 512 + c0) = o;
    }
}
__device__ __forceinline__ void nv_topk(KArgs& a, unsigned char* lds, int t) {
    const f16_t* qi = (const f16_t*)(a.ws + WS_QI); const f16_t* ki = (const f16_t*)(a.ws + WS_KI); const float* wi = (const float*)(a.ws + WS_WI);
    unsigned short* out = (unsigned short*)(a.ws + WS_IDX) + (size_t)t * TOPK;
    LAS unsigned* key = lptr<unsigned>(lds, 0);
    LAS float* qs = lptr<float>(lds, 65536);
    LAS unsigned* sc = lptr<unsigned>(lds, 65536 + 2048);
    const int tid = tid_opaque(), lane = tid & 63, wv = tid >> 6, N = (t / 64 + 1) * 64;
    if (N <= TOPK) { if (tid < N) out[tid] = (unsigned short)tid; return; }
    qs[tid] = (float)qi[(size_t)t * 512 + tid];
    float w[8];
#pragma unroll
    for (int h = 0; h < 8; ++h) w[h] = wi[(size_t)t * 8 + h];
    __syncthreads();
    for (int s = tid; s < N; s += NT) {
        asm volatile("" ::: "memory");
        const uint4* kp = (const uint4*)(ki + (size_t)s * 64);
        uint4 kq[8];
#pragma unroll
        for (int j = 0; j < 8; ++j) kq[j] = kp[j];
        float score = 0.f;
#pragma unroll
        for (int h = 0; h < 8; ++h) {
            float d = 0.f;
#pragma unroll
            for (int j = 0; j < 8; ++j) { const LAS float* q = qs + h * 64 + j * 8; const uint4 u = kq[j];
                d += q[0] * h2f_lo(u.x) + q[1] * h2f_hi(u.x) + q[2] * h2f_lo(u.y) + q[3] * h2f_hi(u.y) + q[4] * h2f_lo(u.z) + q[5] * h2f_hi(u.z) + q[6] * h2f_lo(u.w) + q[7] * h2f_hi(u.w); }
            score += w[h] * fmaxf(d, 0.f);
        }
        unsigned u = __float_as_uint(score); u = (u & 0x80000000u) ? ~u : (u | 0x80000000u);
        key[s] = u;
    }
    __syncthreads();
    unsigned T = 0;
    for (int bit = 31; bit >= 0; --bit) {
        const unsigned cand = T | (1u << bit);
        if (tid == 0) sc[0] = 0;
        __syncthreads();
        unsigned c = 0;
        for (int s = tid; s < N; s += NT) c += (key[s] >= cand) ? 1u : 0u;
        __hip_atomic_fetch_add(&sc[0], c, __ATOMIC_RELAXED, __HIP_MEMORY_SCOPE_WORKGROUP);
        __syncthreads();
        if (sc[0] >= (unsigned)TOPK) T = cand;
        __syncthreads();
    }
    if (tid == 0) sc[0] = 0;
    __syncthreads();
    for (int s = tid; s < N; s += NT) if (key[s] > T) { const unsigned p = __hip_atomic_fetch_add(&sc[0], 1u, __ATOMIC_RELAXED, __HIP_MEMORY_SCOPE_WORKGROUP); out[p] = (unsigned short)s; }
    __syncthreads();
    const unsigned ngt = sc[0], need = TOPK - ngt;
    __syncthreads();
    unsigned base = 0;
    for (int s0 = 0; s0 < N; s0 += NT) {
        const int s = s0 + tid;
        const bool eq = (s < N) && (key[s] == T);
        const unsigned long long m = __ballot(eq);
        if (lane == 0) sc[1 + wv] = (unsigned)__popcll(m);
        __syncthreads();
        unsigned r = base, tot = 0;
#pragma unroll
        for (int q = 0; q < 8; ++q) { const unsigned cq = sc[1 + q]; if (q < wv) r += cq; tot += cq; }
        r += (unsigned)__popcll(m & ((1ull << lane) - 1ull));
        if (eq && r < need) out[ngt + r] = (unsigned short)s;
        base += tot;
        __syncthreads();
    }
}
__device__ __forceinline__ void nv_dsa_attn(KArgs& a, unsigned char* lds, int t) {
    const bf16_t* q = (const bf16_t*)(a.ws + WS_Q0); const bf16_t* k = (const bf16_t*)(a.ws + WS_K0); const bf16_t* v = (const bf16_t*)(a.ws + WS_V0);
    const unsigned short* idx = (const unsigned short*)(a.ws + WS_IDX); bf16_t* y = (bf16_t*)(a.ws + WS_Y0);
    LAS float* p = lptr<float>(lds, 72 * 1024);
    LAS float* qs = lptr<float>(lds, 80 * 1024);
    LAS int* sid = lptr<int>(lds, 82 * 1024);
    LAS float* red = lptr<float>(lds, 83 * 1024);
    const int tid = tid_opaque();
    const int N = (t / 64 + 1) * 64, cnt = N < TOPK ? N : TOPK;
    qs[tid] = bf2f(q[(size_t)t * 512 + tid]);
    int id = 0;
    if (tid < 256) { id = tid < cnt ? (int)idx[(size_t)t * TOPK + tid] : 0; sid[tid] = id; }
    __syncthreads();
    if (tid < cnt) {
        const float dist = fabsf((float)(t - id));
        const uint4* kp = (const uint4*)(k + (size_t)id * 512);
#pragma unroll
        for (int h = 0; h < 8; ++h) {
            float d = 0.f;
#pragma unroll
            for (int j = 0; j < 8; ++j) d += dot8q(qs + h * 64 + j * 8, kp[h * 8 + j]);
            p[h * 256 + tid] = d - exp2f(-(float)(h + 1)) * dist;
        }
    }
    __syncthreads();
    if (tid < 8) {
        float m = -3.0e38f;
        for (int j = 0; j < cnt; ++j) m = fmaxf(m, p[tid * 256 + j]);
        float s = 0.f;
        for (int j = 0; j < cnt; ++j) s += __expf(p[tid * 256 + j] - m);
        red[tid * 2] = m; red[tid * 2 + 1] = 1.f / s;
    }
    __syncthreads();
    if (tid < cnt) {
#pragma unroll
        for (int h = 0; h < 8; ++h) p[h * 256 + tid] = __expf(p[h * 256 + tid] - red[h * 2]) * red[h * 2 + 1];
    }
    __syncthreads();
    {
        const int c = tid, h = c >> 6;
        float acc = 0.f;
        for (int j = 0; j < cnt; ++j) acc += p[h * 256 + j] * bf2f(v[(size_t)sid[j] * 512 + c]);
        y[(size_t)t * 1024 + c] = f2bf(acc);
    }
}
__device__ __forceinline__ void nv_ffn_up(const bf16_t* xb, const bf16_t* wup, const float* bias, const float* cw, bf16_t* g, int bid, int nb) {
    const int vb = tid_opaque() >> 8, tl = tid_opaque() & 255;
    for (int it = bid * 2 + vb; it < 11 * (S / 8); it += nb * 2) {
        const int j = (it % 11) * 256 + tl, t0 = (it / 11) * 8;
        const int nv = 256 * (j >> 7) + (j & 127), ng = nv + 128;
        float uv[10], ug[10];
#pragma unroll
        for (int i = 0; i < 10; ++i) { uv[i] = 0.f; ug[i] = 0.f; }
        const bf16_t* wv = wup + (size_t)nv * D; const bf16_t* wg = wup + (size_t)ng * D;
        for (int k = 0; k < D; k += 8) {
            const uint4 av = *(const uint4*)(wv + k), bv = *(const uint4*)(wg + k);
#pragma unroll
            for (int i = 0; i < 10; ++i) {
                int r = t0 - 2 + i; if (r < 0) r = 0;
                const uint4 x = *(const uint4*)(xb + (size_t)r * D + k);
                uv[i] += dot8(x, av); ug[i] += dot8(x, bv);
            }
        }
        const float bvv = bias[nv], bgt = bias[ng];
#pragma unroll
        for (int i = 0; i < 10; ++i) { const bool ok = (t0 - 2 + i) >= 0; uv[i] = ok ? uv[i] + bvv : 0.f; ug[i] = ok ? ug[i] + bgt : 0.f; }
        const float cv0 = cw[j], cv1 = cw[DFF2 + j], cv2 = cw[2 * DFF2 + j];
        const float cg0 = cw[DFF + j], cg1 = cw[DFF2 + DFF + j], cg2 = cw[2 * DFF2 + DFF + j];
#pragma unroll
        for (int i = 0; i < 8; ++i) {
            const float val = cv0 * uv[i] + cv1 * uv[i + 1] + cv2 * uv[i + 2];
            const float gat = cg0 * ug[i] + cg1 * ug[i + 1] + cg2 * ug[i + 2];
            g[(size_t)(t0 + i) * DFF + j] = f2bf(silu_f(gat) * val);
        }
    }
}
__device__ __forceinline__ void ph_l1_prep(KArgs& a, int bid, int nb) {
    const bf16_t* z1 = (const bf16_t*)(a.ws + WS_Z1); const float* rope = (const float*)(a.ws + WS_ROPE);
    bf16_t* pl = (bf16_t*)(a.ws + WS_PL); float* rs = (float*)(a.ws + WS_RS); bf16_t* kr = (bf16_t*)(a.ws + WS_KR);
    const int lane = tid_opaque() & 63, wave = tid_opaque() >> 6;
    for (int t = bid * 8 + wave; t < S; t += nb * 8) {
        const bf16_t* zr = z1 + (size_t)t * ODD_IN_P;
        {
            const int c0 = lane * 8, win = 2 << (lane >> 4);
            const int lo = (t + 1 - win) > 0 ? (t + 1 - win) : 0;
            float sm[8];
#pragma unroll
            for (int e = 0; e < 8; ++e) sm[e] = 0.f;
            for (int r = lo; r <= t; ++r) {
                const uint4 u = *(const uint4*)(z1 + (size_t)r * ODD_IN_P + c0);
                sm[0] += bflo(u.x); sm[1] += bfhi(u.x); sm[2] += bflo(u.y); sm[3] += bfhi(u.y); sm[4] += bflo(u.z); sm[5] += bfhi(u.z); sm[6] += bflo(u.w); sm[7] += bfhi(u.w);
            }
            const float ic = 1.f / (float)(t + 1 - lo);
            const uint4 u = *(const uint4*)(zr + c0);
            uint4 o; o.x = pk2(sm[0] * ic - bflo(u.x), sm[1] * ic - bfhi(u.x)); o.y = pk2(sm[2] * ic - bflo(u.y), sm[3] * ic - bfhi(u.y));
            o.z = pk2(sm[4] * ic - bflo(u.z), sm[5] * ic - bfhi(u.z)); o.w = pk2(sm[6] * ic - bflo(u.w), sm[7] * ic - bfhi(u.w));
            *(uint4*)(pl + (size_t)t * 512 + c0) = o;
        }
        {
            float sq = 0.f;
#pragma unroll
            for (int j = 0; j < 3; ++j) { const unsigned u = *(const unsigned*)(zr + 512 + 128 * j + lane * 2); sq += bflo(u) * bflo(u) + bfhi(u) * bfhi(u); }
            sq = wave_sum(sq);
            const uint2 u2 = *(const uint2*)(zr + 896 + lane * 4);
            float sk = bflo(u2.x) * bflo(u2.x) + bfhi(u2.x) * bfhi(u2.x) + bflo(u2.y) * bflo(u2.y) + bfhi(u2.y) * bfhi(u2.y);
            sk = wave_sum(sk);
            if (lane == 0) { rs[(size_t)t * 2] = 1.f / sqrtf(sq * (1.f / 384.f) + RMS_EPS); rs[(size_t)t * 2 + 1] = 1.f / sqrtf(sk * (1.f / 256.f) + RMS_EPS); }
        }
        if (lane < 16) {
            const float x1 = bf2f(zr[1152 + lane]), x2 = bf2f(zr[1168 + lane]);
            const float c = rope[(size_t)t * 16 + lane], s = rope[(size_t)S * 16 + (size_t)t * 16 + lane];
            *(unsigned*)(kr + (size_t)t * 32 + 2 * lane) = pk2(x1 * c - x2 * s, x2 * c + x1 * s);
        }
    }
}
__device__ __forceinline__ void nv_mla(KArgs& a, unsigned char* lds, int t, int h) {
    const bf16_t* q1 = (const bf16_t*)(a.ws + WS_Q1); const bf16_t* k1 = (const bf16_t*)(a.ws + WS_K1); const bf16_t* kr = (const bf16_t*)(a.ws + WS_KR);
    const bf16_t* vt = (const bf16_t*)(a.ws + WS_VT); bf16_t* y = (bf16_t*)(a.ws + WS_Y1);
    LAS float* lg = lptr<float>(lds, 0);
    LAS float* qs = lptr<float>(lds, 65536);
    LAS float* red = lptr<float>(lds, 65536 + 512);
    const int tid = tid_opaque(), lane = tid & 63, wv = tid >> 6;
    const int N = (t / 64 + 1) * 64;
    if (tid < 96) qs[tid] = bf2f(q1[(size_t)t * 768 + h * 96 + tid]);
    __syncthreads();
    float m = -3.0e38f;
    for (int s = tid; s < N; s += NT) {
        asm volatile("" ::: "memory");
        const uint4* kp = (const uint4*)(k1 + (size_t)s * 512 + h * 64);
        float d = 0.f;
#pragma unroll
        for (int j = 0; j < 8; ++j) d += dot8q(qs + j * 8, kp[j]);
        const uint4* rp = (const uint4*)(kr + (size_t)s * 32);
#pragma unroll
        for (int j = 0; j < 4; ++j) d += dot8q(qs + 64 + j * 8, rp[j]);
        lg[s] = d; m = fmaxf(m, d);
    }
    m = wave_max(m);
    if (lane == 0) red[wv] = m;
    __syncthreads();
    m = red[0];
#pragma unroll
    for (int q = 1; q < 8; ++q) m = fmaxf(m, red[q]);
    __syncthreads();
    float sum = 0.f;
    for (int s = tid; s < N; s += NT) { const float pp = exp2f(lg[s] - m); lg[s] = pp; sum += pp; }
    sum = wave_sum(sum);
    if (lane == 0) red[wv] = sum;
    __syncthreads();
    float tot = 0.f;
#pragma unroll
    for (int q = 0; q < 8; ++q) tot += red[q];
    const float inv = 1.f / tot;
    for (int dd = 0; dd < 8; ++dd) {
        const int d = wv * 8 + dd;
        const bf16_t* vp = vt + (size_t)(h * 64 + d) * S;
        float acc = 0.f;
        for (int s = lane; s < N; s += 64) acc += lg[s] * bf2f(vp[s]);
        acc = wave_sum(acc);
        if (lane == 0) y[(size_t)t * 1024 + 512 + h * 64 + d] = f2bf(acc * inv);
    }
    __syncthreads();
}

constexpr int N_PHASES = 18;
__global__ void __launch_bounds__(NT, 2) mega(Args  ) {
    extern __shared__ __attribute__((aligned(16))) unsigned char lds[];
    const int tid = tid_opaque(), bid = blockIdx.x, nb = gridDim.x;
    for (int u = tid; u < (LDS_BYTES - LDSCTL_OFF) / 4; u += NT) ((LAS unsigned*)((LAS unsigned char*)lds + LDSCTL_OFF))[u] = 0u;
    __syncthreads();
    volatile LAS unsigned* MISC = (volatile LAS unsigned*)((LAS unsigned char*)lds + MISC_OFF);
    const int ph_lo = kargs().ph_lo, ph_hi = kargs().ph_hi;
    XcdBarrier bar = xcd_barrier_post((unsigned*)(kargs().ws + WS_CTL) + CW_BAR, MISC + 8);
#define IN(k) (ph_lo <= (k) && (k) < ph_hi)
#define SEAM(k) do { if (ph_lo <= (k) && (k) + 1 < ph_hi) xcd_barrier(bar); } while (0)
#define WSP(T, off) ((T*)(ws + (off)))

    if (IN(0)) { KArgs& a = kargs(); ph_mod(a, lds, bid, nb); }
    SEAM(0);
    if (IN(1)) { KArgs& a = kargs(); ph_prep(a, lds, bid, nb); }
    SEAM(1);
    if (IN(2)) { KArgs& a = kargs(); unsigned char* ws = a.ws;
        run_gemm(lds, WSP(const bf16_t, WS_XB), D, WSP(const bf16_t, WS_W_IN0), D, S, EVEN_IN_P, D,
                 EpiIn0{WSP(const float, WS_BIAS_IN0), WSP(bf16_t, WS_Q0), WSP(bf16_t, WS_K0), WSP(bf16_t, WS_V0), WSP(bf16_t, WS_BG), WSP(bf16_t, WS_CG), WSP(bf16_t, WS_XC),
                        WSP(f16_t, WS_QI), WSP(f16_t, WS_KI), WSP(float, WS_WI)}, nb, bid); }
    SEAM(2);
    if (IN(3)) { KArgs& a = kargs();
        ph_shortconv(a, bid, nb);
        for (int t = bid; t < S; t += nb) { nv_topk(a, lds, t); __syncthreads(); nv_dsa_attn(a, lds, t); __syncthreads(); }
    }
    SEAM(3);
    if (IN(4)) { KArgs& a = kargs(); unsigned char* ws = a.ws;
        run_gemm(lds, WSP(const bf16_t, WS_Y0), D, WSP(const bf16_t, WS_W_OUT0), D, S, D, D, EpiResid{a.x, a.out}, nb, bid); }
    SEAM(4);
    if (IN(5)) { KArgs& a = kargs(); ph_ln(a.out, a.ln_mix_g, a.ln_mix_b, (bf16_t*)(a.ws + WS_XB), bid, nb); }
    SEAM(5);
    if (IN(6)) { KArgs& a = kargs(); unsigned char* ws = a.ws;
        nv_ffn_up(WSP(const bf16_t, WS_XB), WSP(const bf16_t, WS_W_UP0), WSP(const float, WS_BIAS_UP0), a.ffn_conv_w, WSP(bf16_t, WS_G), bid, nb); }
    SEAM(6);
    if (IN(7)) { KArgs& a = kargs(); unsigned char* ws = a.ws;
        run_gemm(lds, WSP(const bf16_t, WS_G), DFF, WSP(const bf16_t, WS_W_DN0), DFF, S, D, DFF, EpiResid{a.out, a.out}, nb, bid); }
    SEAM(7);
    if (IN(8)) { KArgs& a = kargs(); ph_ln(a.out, a.ln_ffn_g, a.ln_ffn_b, (bf16_t*)(a.ws + WS_XB), bid, nb); }
    SEAM(8);
    if (IN(9)) { KArgs& a = kargs(); unsigned char* ws = a.ws;
        run_gemm(lds, WSP(const bf16_t, WS_XB), D, WSP(const bf16_t, WS_W_IN1), D, S, ODD_IN_P, D, EpiBiasBf16{WSP(const float, WS_BIAS_IN1), WSP(bf16_t, WS_Z1), ODD_IN_P}, nb, bid); }
    SEAM(9);
    if (IN(10)) { KArgs& a = kargs(); ph_l1_prep(a, bid, nb); }
    SEAM(10);
    if (IN(11)) {
        { KArgs& a = kargs(); unsigned char* ws = a.ws;
          run_gemm(lds, WSP(const bf16_t, WS_PL), 512, WSP(const bf16_t, WS_W_POOL), 512, S, 512, 512, EpiPlainBf16{WSP(bf16_t, WS_Y1), 1024}, nb, bid); }
        { KArgs& a = kargs(); unsigned char* ws = a.ws;
          run_gemm(lds, WSP(const bf16_t, WS_Z1) + 512, ODD_IN_P, WSP(const bf16_t, WS_W_UQ), 384, S, 768, 384, EpiQ1{WSP(const float, WS_RS), WSP(const float, WS_ROPE), WSP(bf16_t, WS_Q1)}, nb, bid); }
        { KArgs& a = kargs(); unsigned char* ws = a.ws;
          run_gemm(lds, WSP(const bf16_t, WS_Z1) + 896, ODD_IN_P, WSP(const bf16_t, WS_W_UK), 256, S, 512, 256, EpiRowScaleBf16{WSP(const float, WS_RS), 1, WSP(bf16_t, WS_K1), 512}, nb, bid); }
        { KArgs& a = kargs(); unsigned char* ws = a.ws;
          run_gemm(lds, WSP(const bf16_t, WS_W_UV), 256, WSP(const bf16_t, WS_Z1) + 896, ODD_IN_P, 512, S, 256, EpiColScaleBf16{WSP(const float, WS_RS), 1, WSP(bf16_t, WS_VT), S}, nb, bid); }
    }
    SEAM(11);
    if (IN(12)) { KArgs& a = kargs(); for (int it = bid; it < S * 8; it += nb) nv_mla(a, lds, it >> 3, it & 7); }
    SEAM(12);
    if (IN(13)) { KArgs& a = kargs(); unsigned char* ws = a.ws;
        run_gemm(lds, WSP(const bf16_t, WS_Y1), D, WSP(const bf16_t, WS_W_OUT1), D, S, D, D, EpiResid{a.out, a.out}, nb, bid); }
    SEAM(13);
    if (IN(14)) { KArgs& a = kargs(); ph_ln(a.out, a.ln_mix_g + D, a.ln_mix_b + D, (bf16_t*)(a.ws + WS_XB), bid, nb); }
    SEAM(14);
    if (IN(15)) { KArgs& a = kargs(); unsigned char* ws = a.ws;
        nv_ffn_up(WSP(const bf16_t, WS_XB), WSP(const bf16_t, WS_W_UP1), WSP(const float, WS_BIAS_UP1), a.ffn_conv_w + (size_t)3 * DFF2, WSP(bf16_t, WS_G), bid, nb); }
    SEAM(15);
    if (IN(16)) { KArgs& a = kargs(); unsigned char* ws = a.ws;
        run_gemm(lds, WSP(const bf16_t, WS_G), DFF, WSP(const bf16_t, WS_W_DN1), DFF, S, D, DFF, EpiResid{a.out, a.out}, nb, bid); }
    SEAM(16);
    if (IN(17)) { KArgs& a = kargs(); ph_ln(a.out, a.ln_ffn_g + D, a.ln_ffn_b + D, (bf16_t*)(a.ws + WS_XB), bid, nb); }
#undef IN
#undef SEAM
#undef WSP
}

extern "C" void kernel_launch(void* const* d_in, const int* in_sizes, int n_in, void* d_out, int out_size, void* d_ws, size_t ws_size, hipStream_t stream) {
    static int grid = 0;
    if (grid == 0) {
        if (n_in != 22 || out_size != S * D || ws_size < WS_END) { fprintf(stderr, "kernel_launch: unexpected problem (n_in %d out %d ws %zu)\n", n_in, out_size, ws_size); grid = -1; return; }
        int dev = 0, cus = 0;
        if (hipGetDevice(&dev) != hipSuccess || hipDeviceGetAttribute(&cus, hipDeviceAttributeMultiprocessorCount, dev) != hipSuccess) { grid = -1; return; }
        if (hipFuncSetAttribute((const void*)mega, hipFuncAttributeMaxDynamicSharedMemorySize, LDS_BYTES) != hipSuccess) { fprintf(stderr, "kernel_launch: hipFuncSetAttribute failed\n"); grid = -1; return; }
        grid = cus;
    }
    if (grid < 0) return;
    if (hipMemsetAsync((char*)d_ws + WS_CTL, 0, CTL_ZERO_BYTES, stream) != hipSuccess) return;
    Args a{};
    const float** ap = (const float**)&a;
    for (int i = 0; i < 22; ++i) ap[i] = (const float*)d_in[i];
    a.out = (float*)d_out; a.ws = (unsigned char*)d_ws;
#if MK_SPLIT
    for (int p = 0; p < N_PHASES; ++p) { a.ph_lo = p; a.ph_hi = p + 1; hipLaunchKernelGGL(mega, dim3(grid), dim3(NT), LDS_BYTES, stream, a); }
#else
    a.ph_lo = 0; a.ph_hi = N_PHASES;
    hipLaunchKernelGGL(mega, dim3(grid), dim3(NT), LDS_BYTES, stream, a);
#endif
}
```

```cpp
#include <hip/hip_runtime.h>
#include <cstdint>
#include <cstdio>

typedef unsigned short bf16_t;
typedef _Float16 f16_t;

#ifndef MK_SPLIT
#define MK_SPLIT 0
#endif

constexpr int S = 16384, D = 1024;
constexpr int EVEN_IN = 3656, EVEN_IN_P = 3840;
constexpr int ODD_IN = 1184, ODD_IN_P = 1280;
constexpr int DFF = 2816, DFF2 = 5632;
constexpr int TOPK = 256;
constexpr float DN_ALPHA = 1.41421356237309515f;
constexpr float LN_EPS = 1e-5f, RMS_EPS = 1e-6f;
constexpr float MLA_QSCALE = 0.14724444602590306f;
constexpr int NT = 512;

constexpr size_t MiB = 1u << 20;
constexpr size_t WS_CTL = 0, CTL_ZERO_BYTES = 1 * MiB;
constexpr size_t WS_MOD = 1 * MiB;
constexpr size_t WS_BIAS_IN0 = 1 * MiB + 64 * 1024;
constexpr size_t WS_BIAS_UP0 = 1 * MiB + 96 * 1024;
constexpr size_t WS_BIAS_IN1 = 1 * MiB + 128 * 1024;
constexpr size_t WS_BIAS_UP1 = 1 * MiB + 160 * 1024;
constexpr size_t WS_RS = 1 * MiB + 256 * 1024;
constexpr size_t WS_ROPE = 2 * MiB;
constexpr size_t WS_W_IN0 = 4 * MiB;
constexpr size_t WS_W_OUT0 = 12 * MiB;
constexpr size_t WS_W_UP0 = 14 * MiB;
constexpr size_t WS_W_DN0 = 25 * MiB;
constexpr size_t WS_W_IN1 = 31 * MiB;
constexpr size_t WS_W_POOL = 34 * MiB;
constexpr size_t WS_W_UQ = 35 * MiB;
constexpr size_t WS_W_UK = 36 * MiB;
constexpr size_t WS_W_UV = 36 * MiB + 512 * 1024;
constexpr size_t WS_W_OUT1 = 37 * MiB;
constexpr size_t WS_W_UP1 = 39 * MiB;
constexpr size_t WS_W_DN1 = 50 * MiB;
constexpr size_t WS_XB = 56 * MiB;
constexpr size_t WS_Q0 = 88 * MiB, WS_K0 = 104 * MiB, WS_V0 = 120 * MiB;
constexpr size_t WS_QI = 136 * MiB;
constexpr size_t WS_BG = 152 * MiB, WS_CG = 168 * MiB, WS_XC = 184 * MiB;
constexpr size_t WS_KI = 200 * MiB;
constexpr size_t WS_WI = 202 * MiB;
constexpr size_t WS_IDX = 203 * MiB;
constexpr size_t WS_Y0 = 212 * MiB;
constexpr size_t WS_G = 88 * MiB;
constexpr size_t WS_HU = 176 * MiB;
constexpr size_t WS_Z1 = 88 * MiB;
constexpr size_t WS_PL = 128 * MiB;
constexpr size_t WS_Q1 = 144 * MiB;
constexpr size_t WS_K1 = 168 * MiB;
constexpr size_t WS_KR = 184 * MiB;
constexpr size_t WS_VT = 186 * MiB;
constexpr size_t WS_Y1 = 202 * MiB;
constexpr size_t WS_END = 256 * MiB;

constexpr int CW_BAR = 4096;

constexpr int RING_BYTES = 131072;
constexpr int LDSCTL_OFF = RING_BYTES, MISC_OFF = LDSCTL_OFF + 320;
constexpr int LDS_BYTES = 147456;

#define GAS __attribute__((address_space(1)))
#define LAS __attribute__((address_space(3)))
typedef GAS unsigned gu32;
#define LDS_WAIT() asm volatile("s_waitcnt lgkmcnt(0)" ::: "memory")
__device__ __forceinline__ float bf2f(bf16_t h) { return __uint_as_float(((unsigned)h) << 16); }
__device__ __forceinline__ bf16_t f2bf(float f) { unsigned u = __float_as_uint(f); return (bf16_t)((u + 0x7fffu + ((u >> 16) & 1u)) >> 16); }
__device__ __forceinline__ unsigned pk2(float lo, float hi) { return (unsigned)f2bf(lo) | ((unsigned)f2bf(hi) << 16); }
__device__ __forceinline__ float bflo(unsigned w) { return __uint_as_float(w << 16); }
__device__ __forceinline__ float bfhi(unsigned w) { return __uint_as_float(w & 0xffff0000u); }
__device__ __forceinline__ float h2f_lo(unsigned w) { return (float)__builtin_bit_cast(_Float16, (unsigned short)(w & 0xffffu)); }
__device__ __forceinline__ float h2f_hi(unsigned w) { return (float)__builtin_bit_cast(_Float16, (unsigned short)(w >> 16)); }
__device__ __forceinline__ float wave_sum(float v) {
#pragma unroll
    for (int o = 1; o < 64; o <<= 1) v += __shfl_xor(v, o);
    return v;
}
__device__ __forceinline__ float wave_max(float v) {
#pragma unroll
    for (int o = 1; o < 64; o <<= 1) v = fmaxf(v, __shfl_xor(v, o));
    return v;
}
__device__ __forceinline__ float silu_f(float v) { return v / (1.f + __expf(-v)); }
__device__ __forceinline__ float dot8(const uint4 a, const uint4 b) {
    return bflo(a.x) * bflo(b.x) + bfhi(a.x) * bfhi(b.x) + bflo(a.y) * bflo(b.y) + bfhi(a.y) * bfhi(b.y)
         + bflo(a.z) * bflo(b.z) + bfhi(a.z) * bfhi(b.z) + bflo(a.w) * bflo(b.w) + bfhi(a.w) * bfhi(b.w);
}
template <class P> __device__ __forceinline__ float dot8q(P q, const uint4 u) {
    return q[0] * bflo(u.x) + q[1] * bfhi(u.x) + q[2] * bflo(u.y) + q[3] * bfhi(u.y) + q[4] * bflo(u.z) + q[5] * bfhi(u.z) + q[6] * bflo(u.w) + q[7] * bfhi(u.w);
}

__device__ __forceinline__ int hw_lane() { unsigned z = 0u; asm volatile("" : "+s"(z)); return (int)__builtin_amdgcn_mbcnt_hi(~0u, __builtin_amdgcn_mbcnt_lo(~0u, z)); }
__device__ __forceinline__ int tid_opaque(int wv) { int t = (wv << 6) | hw_lane(); asm volatile("" : "+v"(t)); return t; }
template <class T> __device__ __forceinline__ LAS T* lptr(unsigned char* lds, int off) {
    unsigned b = (unsigned)(uintptr_t)((LAS unsigned char*)lds + off);
    asm volatile("" : "+s"(b));
    return (LAS T*)(uintptr_t)b;
}
__constant__ float c_inv_freq[16] = {1.0f, 0.5623413324356079f, 0.3162277638912201f, 0.17782793939113617f, 0.10000000149011612f, 0.05623413249850273f,
    0.03162277489900589f, 0.017782794311642647f, 0.009999999776482582f, 0.005623413249850273f, 0.003162277629598975f, 0.0017782794311642647f,
    0.0010000000474974513f, 0.000562341301701963f, 0.0003162277571391314f, 0.00017782794020604342f};

namespace pg8 {
#define PG8_LAS __attribute__((address_space(3)))
typedef unsigned short bf16_t;
typedef short bf16x8 __attribute__((ext_vector_type(8)));
typedef float f32x4 __attribute__((ext_vector_type(4)));
typedef unsigned u32x4 __attribute__((ext_vector_type(4)));
constexpr int BM = 256, BK = 64, HALF = 128, HTB = HALF * BK * 2  , STAGE_BYTES = 8 * HTB, NXCD = 8, WGM = 8;

__host__ __device__ __forceinline__ int lds_byte(int r, int c) { const int st = (r >> 4) * 2 + (c >> 5), rr = r & 15, cc = c & 31, ob = rr * 64 + cc * 2; return st * 1024 + (ob ^ (((ob >> 9) & 1) << 5)); }
__host__ __device__ __forceinline__ void stage_rc(int b, int& R, int& C) { const int st = b / 1024, sb = b % 1024, swz = sb ^ (((sb >> 9) & 1) << 5); R = (st >> 1) * 16 + swz / 64; C = (st & 1) * 32 + (swz % 64) / 2; }
__host__ __device__ __forceinline__ int perm32(int rho) { const int n = rho >> 4, i = rho & 15; return 8 * (i >> 2) + 4 * n + (i & 3); }

struct Unit { int pm, pn; };
struct Gemm { const bf16_t* A; const bf16_t* Bt; int M, N, K, lda, ldb; };

struct StaticOrder {
    int nM, nN, nwg, G, c;
    __host__ __device__ void init(int M, int N, int G_, int c_) { nM = M / BM; nN = N / BM; nwg = nM * nN; G = G_; c = c_; }
    __host__ __device__ bool next(int i, Unit& u) const {
        const long L = (long)i * G + c; if (L >= nwg) return false;
        int wgid = (int)L; { const int q = nwg / NXCD, r = nwg % NXCD, xcd = wgid % NXCD, off = wgid / NXCD; wgid = (xcd < r ? xcd * (q + 1) : r * (q + 1) + (xcd - r) * q) + off; }
        const int nig = WGM * nN, gid = wgid / nig, fm = gid * WGM, gsz = (nM - fm) < WGM ? (nM - fm) : WGM;
        u.pm = fm + ((wgid % nig) % gsz); u.pn = (wgid % nig) / gsz; return true;
    }
    __device__ __forceinline__ void a_ready(const Unit&) const {}
    __device__ __forceinline__ void done(const Unit&) const {}
};

__device__ __forceinline__ unsigned cvt_pk_bf16(float lo, float hi) { unsigned r; asm volatile("v_cvt_pk_bf16_f32 %0, %1, %2" : "=v"(r) : "v"(lo), "v"(hi)); return r; }
template <class Epi, class Sched, bool ALIGN_EPI = false, bool SP2 = false>
__device__ __forceinline__ void gemm_phase(PG8_LAS unsigned char* lds, const Gemm g, const Sched& S, const Epi& E, int wv_in) {
    unsigned z_ = 0u; asm volatile("" : "+s"(z_)); int tid = (wv_in << 6) | (int)__builtin_amdgcn_mbcnt_hi(~0u, __builtin_amdgcn_mbcnt_lo(~0u, z_)); asm volatile("" : "+v"(tid)); const int wid = __builtin_amdgcn_readfirstlane(tid >> 6), lane = tid & 63, wr = wid >> 2, wc = wid & 3, fr = lane & 15, fq = lane >> 4;
    const int K = g.K, nt = K / BK;
    unsigned voffA[2], voffB[2];
#pragma unroll
    for (int i = 0; i < 2; ++i) { int R, C; stage_rc(tid * 16 + i * 8192, R, C); const int Rb = Epi::PERM ? ((R & ~31) + perm32(R & 31)) : R;
        voffA[i] = (unsigned)(R * g.lda + C) * 2u; voffB[i] = (unsigned)(Rb * g.ldb + C) * 2u; }
    const size_t kstep = (size_t)(BK * 2);
    const size_t hstepA = (size_t)HALF * g.lda * 2, hstepB = (size_t)HALF * g.ldb * 2;
    const size_t tstepA = 2 * hstepA, tstepB = 2 * hstepB;
    const unsigned ldsw = (unsigned)wid * 1024u;
    const int aoff = lds_byte(wr * 64 + fr, fq * 8), boff = lds_byte(wc * 32 + fr, fq * 8);
#define PG8_SA(b, h) (((b) * 2 + (h)) * HTB)
#define PG8_SB(b, h) ((4 + (b) * 2 + (h)) * HTB)
#define PG8_STAGE(bufoff, gbase, voff) do { _Pragma("unroll") for (int _i = 0; _i < 2; ++_i) \
        __builtin_amdgcn_global_load_lds((const unsigned*)((const char*)(gbase) + (voff)[_i]), (PG8_LAS unsigned*)(lds + (bufoff) + ldsw + _i * 8192), 16, 0, 0); } while (0)
#define PG8_LDA(dst, b, h) do { _Pragma("unroll") for (int m = 0; m < 4; ++m) _Pragma("unroll") for (int k = 0; k < 2; ++k) dst[m][k] = *(const PG8_LAS bf16x8*)(lds + PG8_SA(b, h) + aoff + m * 2048 + k * 1024); } while (0)
#define PG8_LDB(dst, b, h) do { _Pragma("unroll") for (int n = 0; n < 2; ++n) _Pragma("unroll") for (int k = 0; k < 2; ++k) dst[n][k] = *(const PG8_LAS bf16x8*)(lds + PG8_SB(b, h) + boff + n * 2048 + k * 1024); } while (0)
#define PG8_MMA(ai, bj, At, Bt) do { __builtin_amdgcn_s_setprio(1); _Pragma("unroll") for (int m = 0; m < 4; ++m) _Pragma("unroll") for (int n = 0; n < 2; ++n) _Pragma("unroll") for (int k = 0; k < 2; ++k) \
        acc[ai][bj][m][n] = __builtin_amdgcn_mfma_f32_16x16x32_bf16(Bt[n][k], At[m][k], acc[ai][bj][m][n], 0, 0, 0); __builtin_amdgcn_s_setprio(0); } while (0)
#define PG8_WAIT_V(n) asm volatile("s_waitcnt vmcnt(" #n ")" ::: "memory")
#define PG8_WAIT_L(n) asm volatile("s_waitcnt lgkmcnt(" #n ")" ::: "memory")
#define PG8_BAR __builtin_amdgcn_s_barrier()
#define PG8_SCHED __builtin_amdgcn_sched_barrier(0)
    Unit cur, nxt; int ui = 0;
    if (!S.next(0, cur)) return;
    f32x4 acc[2][2][4][2];
#pragma unroll
    for (int a = 0; a < 2; ++a)
#pragma unroll
        for (int b = 0; b < 2; ++b)
#pragma unroll
            for (int m = 0; m < 4; ++m)
#pragma unroll
                for (int n = 0; n < 2; ++n) acc[a][b][m][n] = (f32x4){0.f, 0.f, 0.f, 0.f};
    bf16x8 At[4][2], B0[2][2], B1[2][2];
    const char* cA = (const char*)g.A + (size_t)cur.pm * tstepA; const char* cB = (const char*)g.Bt + (size_t)cur.pn * tstepB;
    S.a_ready(cur);
    if constexpr (SP2) {
        PG8_STAGE(PG8_SB(0, 0), cB, voffB); PG8_STAGE(PG8_SB(0, 1), cB + hstepB, voffB); PG8_STAGE(PG8_SA(0, 0), cA, voffA); PG8_STAGE(PG8_SA(0, 1), cA + hstepA, voffA);
        if (wr == 1) PG8_BAR;
        PG8_WAIT_V(2); PG8_BAR;
        PG8_STAGE(PG8_SB(1, 0), cB + kstep, voffB); PG8_STAGE(PG8_SA(1, 0), cA + kstep, voffA); PG8_STAGE(PG8_SB(1, 1), cB + hstepB + kstep, voffB);
        PG8_WAIT_V(6); PG8_BAR;
    } else {
        PG8_STAGE(PG8_SB(0, 0), cB, voffB); PG8_STAGE(PG8_SA(0, 0), cA, voffA); PG8_STAGE(PG8_SB(0, 1), cB + hstepB, voffB); PG8_STAGE(PG8_SA(0, 1), cA + hstepA, voffA);
        if (wr == 1) PG8_BAR;
        PG8_WAIT_V(4); PG8_BAR;
        PG8_STAGE(PG8_SB(1, 0), cB + kstep, voffB); PG8_STAGE(PG8_SA(1, 0), cA + kstep, voffA); PG8_STAGE(PG8_SB(1, 1), cB + hstepB + kstep, voffB);
        PG8_WAIT_V(6); PG8_BAR;
    }
    for (;;) {
        const bool has_next = S.next(ui + 1, nxt);
        const char* nA = has_next ? (const char*)g.A + (size_t)nxt.pm * tstepA : cA; const char* nB = has_next ? (const char*)g.Bt + (size_t)nxt.pn * tstepB : cB;
        for (int t = 0; t < nt; t += 2) {
            const bool last = (t == nt - 2);
            const char* a1 = cA + (size_t)(t + 1) * kstep;
            const char* a2 = last ? nA : cA + (size_t)(t + 2) * kstep; const char* b2 = last ? nB : cB + (size_t)(t + 2) * kstep;
            const char* a3 = a2 + kstep; const char* b3 = b2 + kstep;
            if (last && has_next) S.a_ready(nxt);
            if constexpr (SP2) {
            PG8_LDB(B0, 0, 0); PG8_LDB(B1, 0, 1); PG8_SCHED; PG8_LDA(At, 0, 0); PG8_STAGE(PG8_SA(1, 1), a1 + hstepA, voffA);
            PG8_WAIT_V(8); PG8_WAIT_L(0); PG8_BAR; PG8_MMA(0, 0, At, B0); PG8_MMA(0, 1, At, B1); PG8_BAR; PG8_SCHED;
            PG8_LDA(At, 0, 1); PG8_STAGE(PG8_SB(0, 0), b2, voffB); PG8_STAGE(PG8_SB(0, 1), b2 + hstepB, voffB); PG8_STAGE(PG8_SA(0, 0), a2, voffA);
            PG8_WAIT_V(8); PG8_WAIT_L(0); PG8_BAR; PG8_MMA(1, 0, At, B0); PG8_MMA(1, 1, At, B1); PG8_BAR; PG8_SCHED;
            PG8_LDB(B0, 1, 0); PG8_LDB(B1, 1, 1); PG8_SCHED; PG8_LDA(At, 1, 0); PG8_STAGE(PG8_SA(0, 1), a2 + hstepA, voffA);
            PG8_WAIT_V(8); PG8_WAIT_L(0); PG8_BAR; PG8_MMA(0, 0, At, B0); PG8_MMA(0, 1, At, B1); PG8_BAR; PG8_SCHED;
            PG8_LDA(At, 1, 1); PG8_STAGE(PG8_SB(1, 0), b3, voffB); PG8_STAGE(PG8_SB(1, 1), b3 + hstepB, voffB); PG8_STAGE(PG8_SA(1, 0), a3, voffA);
            PG8_WAIT_V(8); PG8_WAIT_L(0); PG8_BAR; PG8_MMA(1, 0, At, B0); PG8_MMA(1, 1, At, B1); PG8_BAR; PG8_SCHED;
            } else {
            PG8_LDB(B0, 0, 0); PG8_SCHED; PG8_LDA(At, 0, 0); PG8_STAGE(PG8_SA(1, 1), a1 + hstepA, voffA);
            PG8_WAIT_L(8); PG8_BAR; PG8_WAIT_L(0); PG8_MMA(0, 0, At, B0); PG8_BAR; PG8_SCHED;
            PG8_LDB(B1, 0, 1); PG8_STAGE(PG8_SB(0, 0), b2, voffB);
            PG8_BAR; PG8_WAIT_L(0); PG8_MMA(0, 1, At, B1); PG8_BAR;
            PG8_LDA(At, 0, 1); PG8_STAGE(PG8_SA(0, 0), a2, voffA);
            PG8_BAR; PG8_WAIT_L(0); PG8_MMA(1, 0, At, B0); PG8_BAR; PG8_SCHED;
            PG8_STAGE(PG8_SB(0, 1), b2 + hstepB, voffB);
            PG8_WAIT_V(6); PG8_BAR; PG8_MMA(1, 1, At, B1); PG8_BAR;
            PG8_LDB(B0, 1, 0); PG8_SCHED; PG8_LDA(At, 1, 0); PG8_STAGE(PG8_SA(0, 1), a2 + hstepA, voffA);
            PG8_WAIT_L(8); PG8_BAR; PG8_WAIT_L(0); PG8_MMA(0, 0, At, B0); PG8_BAR; PG8_SCHED;
            PG8_LDB(B1, 1, 1); PG8_STAGE(PG8_SB(1, 0), b3, voffB);
            PG8_BAR; PG8_WAIT_L(0); PG8_MMA(0, 1, At, B1); PG8_BAR;
            PG8_LDA(At, 1, 1); PG8_STAGE(PG8_SA(1, 0), a3, voffA);
            PG8_BAR; PG8_WAIT_L(0); PG8_MMA(1, 0, At, B0); PG8_BAR; PG8_SCHED;
            PG8_STAGE(PG8_SB(1, 1), b3 + hstepB, voffB);
            PG8_WAIT_V(6); PG8_BAR; PG8_MMA(1, 1, At, B1); PG8_BAR;
            }
        }
        if constexpr (ALIGN_EPI) { if (wr == 0) PG8_BAR; }
        if constexpr (!Epi::AFTER_DRAIN) { E(acc, cur, wr, wc, fr, fq); S.done(cur); }
        if (!has_next) break;
#pragma unroll
        for (int a = 0; a < 2; ++a)
#pragma unroll
            for (int b = 0; b < 2; ++b)
#pragma unroll
                for (int m = 0; m < 4; ++m)
#pragma unroll
                    for (int n = 0; n < 2; ++n) acc[a][b][m][n] = (f32x4){0.f, 0.f, 0.f, 0.f};
        cur = nxt; cA = nA; cB = nB; ++ui;
        if constexpr (ALIGN_EPI) { if (wr == 1) PG8_BAR; }
    }
    PG8_WAIT_V(0);
    if constexpr (!ALIGN_EPI) { if (wr == 0) PG8_BAR; }
    PG8_BAR;
    if constexpr (Epi::AFTER_DRAIN) { E.fused(acc, cur, wr, wc, fr, fq, lds, wid, lane); S.done(cur); }
#undef PG8_SA
#undef PG8_SB
#undef PG8_STAGE
#undef PG8_LDA
#undef PG8_LDB
#undef PG8_MMA
#undef PG8_WAIT_V
#undef PG8_WAIT_L
#undef PG8_BAR
#undef PG8_SCHED
}
}


#define XB_TMO      128
#define XB_XCNT(j)  (256  + 64 * (j))
#define XB_XSUB(j)  (1280 + 64 * (j))
#define XB_XGEN(j)  (2304 + 64 * (j))
#define XB_TOP      3328
#define XB_TOPGEN   3392
#define XCD_BAR_WORDS 3456
#define XB_SPIN_CAP (1u << 18)

__device__ __forceinline__ unsigned xb_ld(unsigned* p)              { return __hip_atomic_load(p, __ATOMIC_RELAXED, __HIP_MEMORY_SCOPE_AGENT); }
__device__ __forceinline__ unsigned xb_add(unsigned* p, unsigned v) { return __hip_atomic_fetch_add(p, v, __ATOMIC_RELAXED, __HIP_MEMORY_SCOPE_AGENT); }
__device__ __forceinline__ unsigned xb_xcc_id() { return (unsigned)__builtin_amdgcn_s_getreg((3 << 11) | 20) & 0xFu; }
#define XB_SPIN(cond, bar) do { unsigned _sp = 0; while (cond) { __builtin_amdgcn_s_sleep(1); \
    if ((++_sp & 255u) == 0u) { if (xb_ld(&(bar)[XB_TMO])) break; if (_sp > XB_SPIN_CAP) { atomicAdd(&(bar)[XB_TMO], 1u); break; } } } } while (0)

struct XcdBarrier {
    unsigned* bar; unsigned x; int wv;
    volatile LAS unsigned* st;
};

__device__ __forceinline__ XcdBarrier xcd_barrier_post(unsigned* bar, volatile LAS unsigned* st, int wv) {
    XcdBarrier b; b.bar = bar; b.x = xb_xcc_id(); b.st = st;
    b.wv = wv; if (wv == 0 && hw_lane() == 0) (void)xb_add(&bar[XB_XCNT(b.x)], 1u);
    return b;
}
__device__ __forceinline__ void xcd_barrier_complete(unsigned* bar, unsigned x, unsigned& nloc, unsigned& nx) {
    const unsigned G = gridDim.x * gridDim.y * gridDim.z;
    unsigned sum, cnt, mine, sp = 0u;
    for (;;) {
        sum = 0u; cnt = 0u; mine = 0u;
#pragma unroll
        for (unsigned j = 0; j < 16; ++j) { const unsigned c = xb_ld(&bar[XB_XCNT(j)]); sum += c; cnt += (c > 0u) ? 1u : 0u; mine = (j == x) ? c : mine; }
        if (sum == G) break;
        __builtin_amdgcn_s_sleep(1);
        if ((++sp & 255u) == 0u) { if (xb_ld(&bar[XB_TMO])) break; if (sp > XB_SPIN_CAP) { atomicAdd(&bar[XB_TMO], 1u); break; } }
    }
    nloc = mine > 0u ? mine : 1u; nx = cnt > 0u ? cnt : 1u;
}

__device__ __forceinline__ void xcd_barrier(const XcdBarrier& b) {
    asm volatile("s_waitcnt vmcnt(0)" ::: "memory");
    __syncthreads();
    if (b.wv == 0 && hw_lane() == 0) {
        unsigned* bar = b.bar;
        __builtin_amdgcn_s_waitcnt(0);
        unsigned nloc = b.st[0], nx = b.st[1];
        if (nloc == 0u) { xcd_barrier_complete(bar, b.x, nloc, nx); b.st[0] = nloc; b.st[1] = nx; }
        const unsigned old = xb_add(&bar[XB_XSUB(b.x)], 1u);
        const unsigned gen = old / nloc;
        if (old + 1u == (gen + 1u) * nloc) {
            __builtin_amdgcn_fence(__ATOMIC_RELEASE, "agent");
            asm volatile("s_waitcnt vmcnt(0)" ::: "memory");
            const unsigned og = xb_add(&bar[XB_TOP], 1u);
            const unsigned tg = og / nx;
            if (og + 1u == (tg + 1u) * nx) xb_add(&bar[XB_TOPGEN], 1u);
            else XB_SPIN(xb_ld(&bar[XB_TOPGEN]) == tg, bar);
            __builtin_amdgcn_fence(__ATOMIC_ACQUIRE, "agent");
            xb_add(&bar[XB_XGEN(b.x)], 1u);
            asm volatile("s_waitcnt vmcnt(0)" ::: "memory");
        } else {
            XB_SPIN(xb_ld(&bar[XB_XGEN(b.x)]) == gen, bar);
            __builtin_amdgcn_fence(__ATOMIC_ACQUIRE, "agent");
            asm volatile("s_waitcnt vmcnt(0)" ::: "memory");
        }
    }
    __syncthreads();
}


struct Args {
    const float *x, *c, *ada_w, *ada_b, *ln_mix_g, *ln_mix_b, *ln_ffn_g, *ln_ffn_b, *ev_w_in, *ev_conv_w, *ev_w_out, *od_w_in, *pool_w, *pool_scale,
                *q_norm_g, *w_uq, *kv_norm_g, *w_ukv, *od_w_out, *ffn_w_up, *ffn_conv_w, *ffn_w_down;
    float* out; unsigned char* ws; int ph_lo, ph_hi;
};

#define AS4 __attribute__((address_space(4)))
typedef const AS4 Args KArgs;
__device__ __forceinline__ KArgs& kargs() { unsigned z = 0; asm volatile("" : "+s"(z)); return *(KArgs*)((const AS4 char*)__builtin_amdgcn_kernarg_segment_ptr() + z); }

__device__ __forceinline__ void st_bf16x4(bf16_t* p, float a, float b, float c, float d) { uint2 w; w.x = pk2(a, b); w.y = pk2(c, d); *(uint2*)p = w; }
struct EpiIn0 {
    const float* bias; bf16_t *q, *k, *v, *bg, *cg, *xc; f16_t *qi, *ki; float* wi;
    __device__ __forceinline__ void store4(int r, int c, float a, float b, float cc, float d) const {
        if (c >= EVEN_IN) return;
        const float4 bv = *(const float4*)(bias + c); a += bv.x; b += bv.y; cc += bv.z; d += bv.w;
        if (c < 512) { st_bf16x4(q + (size_t)r * 512 + c, a * 0.125f, b * 0.125f, cc * 0.125f, d * 0.125f); return; }
        if (c < 1024) { st_bf16x4(k + (size_t)r * 512 + (c - 512), a, b, cc, d); return; }
        if (c < 1536) { st_bf16x4(v + (size_t)r * 512 + (c - 1024), a, b, cc, d); return; }
        if (c < 2048) { f16_t* p = qi + (size_t)r * 512 + (c - 1536); p[0] = (f16_t)a; p[1] = (f16_t)b; p[2] = (f16_t)cc; p[3] = (f16_t)d; return; }
        if (c < 2112) { f16_t* p = ki + (size_t)r * 64 + (c - 2048); p[0] = (f16_t)a; p[1] = (f16_t)b; p[2] = (f16_t)cc; p[3] = (f16_t)d; return; }
        if (c < 2120) { *(float4*)(wi + (size_t)r * 8 + (c - 2112)) = make_float4(a, b, cc, d); return; }
        if (c < 2632) { st_bf16x4(bg + (size_t)r * 512 + (c - 2120), a, b, cc, d); return; }
        if (c < 3144) { st_bf16x4(cg + (size_t)r * 512 + (c - 2632), a, b, cc, d); return; }
        st_bf16x4(xc + (size_t)r * 512 + (c - 3144), a, b, cc, d);
    }
};
struct EpiResid {
    const float* res; float* pre;
    __device__ __forceinline__ void store4(int r, int c, float a, float b, float cc, float d) const {
        const float4 x = *(const float4*)(res + (size_t)r * D + c);
        *(float4*)(pre + (size_t)r * D + c) = make_float4(DN_ALPHA * x.x + a, DN_ALPHA * x.y + b, DN_ALPHA * x.z + cc, DN_ALPHA * x.w + d);
    }
};
struct EpiBiasBf16 {
    const float* bias; bf16_t* out; int ldc;
    __device__ __forceinline__ void store4(int r, int c, float a, float b, float cc, float d) const {
        const float4 bv = *(const float4*)(bias + c);
        st_bf16x4(out + (size_t)r * ldc + c, a + bv.x, b + bv.y, cc + bv.z, d + bv.w);
    }
};
struct EpiPlainBf16 {
    bf16_t* out; int ldc;
    __device__ __forceinline__ void store4(int r, int c, float a, float b, float cc, float d) const { st_bf16x4(out + (size_t)r * ldc + c, a, b, cc, d); }
};
struct EpiRowScaleBf16 {
    const float* rs; int which; bf16_t* out; int ldc;
    __device__ __forceinline__ void store4(int r, int c, float a, float b, float cc, float d) const {
        const float s = rs[(size_t)r * 2 + which]; st_bf16x4(out + (size_t)r * ldc + c, a * s, b * s, cc * s, d * s);
    }
};
struct EpiColScaleBf16 {
    const float* rs; int which; bf16_t* out; int ldc;
    __device__ __forceinline__ void store4(int r, int c, float a, float b, float cc, float d) const {
        st_bf16x4(out + (size_t)r * ldc + c, a * rs[(size_t)c * 2 + which], b * rs[(size_t)(c + 1) * 2 + which], cc * rs[(size_t)(c + 2) * 2 + which], d * rs[(size_t)(c + 3) * 2 + which]);
    }
};
struct EpiQ1 {
    const float* rs; const float* rope; bf16_t* out;
    __device__ __forceinline__ void store4(int r, int c, float a, float b, float cc, float d) const {
        const float s = rs[(size_t)r * 2]; a *= s; b *= s; cc *= s; d *= s;
        const int e = c % 96;
        if (e >= 64) {
            const int i = (e - 64) >> 1;
            const float c0 = rope[(size_t)r * 16 + i], s0 = rope[(size_t)S * 16 + (size_t)r * 16 + i];
            const float c1 = rope[(size_t)r * 16 + i + 1], s1 = rope[(size_t)S * 16 + (size_t)r * 16 + i + 1];
            const float a2 = a * c0 - b * s0, b2 = b * c0 + a * s0, c2 = cc * c1 - d * s1, d2 = d * c1 + cc * s1;
            a = a2; b = b2; cc = c2; d = d2;
        }
        st_bf16x4(out + (size_t)r * 768 + c, a, b, cc, d);
    }
};
template <class F> struct EpiFn {
    static constexpr bool PERM = true, AFTER_DRAIN = false;
    F f;
    __device__ __forceinline__ void operator()(const pg8::f32x4 (&acc)[2][2][4][2], const pg8::Unit& u, int wr, int wc, int fr, int fq) const {
        { int l = hw_lane(); asm volatile("" : "+v"(l)); fr = l & 15; fq = l >> 4; }
        const int row0 = u.pm * 256 + wr * 64 + fr, col0 = u.pn * 256 + wc * 32 + 8 * fq;
#pragma unroll
        for (int ai = 0; ai < 2; ++ai)
#pragma unroll
            for (int m = 0; m < 4; ++m)
#pragma unroll
                for (int bj = 0; bj < 2; ++bj)
#pragma unroll
                    for (int n = 0; n < 2; ++n) { const pg8::f32x4 v = acc[ai][bj][m][n]; f.store4(row0 + ai * 128 + m * 16, col0 + bj * 128 + 4 * n, v[0], v[1], v[2], v[3]);
                                                  asm volatile("" ::: "memory"); }
    }
};
template <class E>
__device__ __forceinline__ void run_gemm_epi(unsigned char* lds, const bf16_t* A, int lda, const bf16_t* Bt, int ldb, int M, int N, int K, const E& e, int nb, int bid, int wv) {
    asm volatile("" : "+s"(K), "+s"(lda), "+s"(ldb));
    pg8::Gemm g{A, Bt, M, N, K, lda, ldb}; pg8::StaticOrder So; So.init(M, N, nb, bid);
    pg8::gemm_phase<E, pg8::StaticOrder, true, true>((PG8_LAS unsigned char*)lds, g, So, e, wv);
}
template <class F>
__device__ __forceinline__ void run_gemm(unsigned char* lds, const bf16_t* A, int lda, const bf16_t* Bt, int ldb, int M, int N, int K, const F& f, int nb, int bid, int wv) {
    asm volatile("" : "+s"(K), "+s"(lda), "+s"(ldb));
    pg8::Gemm g{A, Bt, M, N, K, lda, ldb}; pg8::StaticOrder So; So.init(M, N, nb, bid);
    EpiFn<F> E{f};
    pg8::gemm_phase<EpiFn<F>, pg8::StaticOrder, true, true>((PG8_LAS unsigned char*)lds, g, So, E, wv);
}

template <int N> __device__ __forceinline__ float prev_row(float prevgroup, float cur) {
    const int t = __builtin_amdgcn_update_dpp(0, __builtin_bit_cast(int, prevgroup), 0x120 + N, 0xf, 0xf, true);
    return __builtin_bit_cast(float, __builtin_amdgcn_update_dpp(t, __builtin_bit_cast(int, cur), 0x110 + N, 0xf, 0xf, false));
}
struct EpiFfnUp {
    static constexpr bool PERM = true, AFTER_DRAIN = false;
    const float* bias; const float* cw; bf16_t* g; bf16_t* hu;
    template <int HALFSEL>
    __device__ __forceinline__ void half(const pg8::f32x4 (&acc)[2][2][4][2], int ai, int n, int fr, const float* bp, const float* cp, bf16_t* h01, bf16_t* h23, float (&o)[4][4]) const {
#pragma unroll
        for (int e = 0; e < 4; ++e) {
            const float be = bp[e], c0e = cp[e], c1e = cp[DFF2 + e], c2e = cp[2 * DFF2 + e];
            float uu[4];
#pragma unroll
            for (int m = 0; m < 4; ++m) uu[m] = acc[ai][HALFSEL][m][n][e] + be;
#pragma unroll
            for (int m = 0; m < 4; ++m) {
                const float p1 = prev_row<1>(uu[m > 0 ? m - 1 : 0], uu[m]), p2 = prev_row<2>(uu[m > 0 ? m - 1 : 0], uu[m]);
                const float cvv = c0e * p2 + c1e * p1 + c2e * uu[m];
                if (HALFSEL == 0) o[m][e] = cvv; else o[m][e] *= silu_f(cvv);
            }
            if (fr < 2) h01[HALFSEL * 128 + e] = f2bf(uu[0]);
            if (fr >= 14) h23[HALFSEL * 128 + e] = f2bf(uu[3]);
            asm volatile("" ::: "memory"); __builtin_amdgcn_sched_barrier(0);
        }
    }
    __device__ __forceinline__ void operator()(const pg8::f32x4 (&acc)[2][2][4][2], const pg8::Unit& u, int wr, int wc, int fr, int fq) const {
        { int l = hw_lane(); asm volatile("" : "+v"(l)); fr = l & 15; fq = l >> 4; }
        const int jl = wc * 32 + 8 * fq, j0 = u.pn * 128 + jl, nb0 = u.pn * 256 + jl;
#pragma unroll
        for (int n = 0; n < 2; ++n) {
#pragma unroll
            for (int ai = 0; ai < 2; ++ai) {
                const int row0 = u.pm * 256 + ai * 128 + wr * 64, blk = row0 >> 6;
                bf16_t* h01 = hu + ((size_t)blk * 4 + (fr & 1)) * DFF2 + nb0 + 4 * n;
                bf16_t* h23 = hu + ((size_t)blk * 4 + 2 + (fr & 1)) * DFF2 + nb0 + 4 * n;
                float o[4][4];
                half<0>(acc, ai, n, fr, bias + nb0 + 4 * n, cw + j0 + 4 * n, h01, h23, o);
                half<1>(acc, ai, n, fr, bias + nb0 + 128 + 4 * n, cw + DFF + j0 + 4 * n, h01, h23, o);
#pragma unroll
                for (int m = 0; m < 4; ++m) {
                    if (m > 0 || fr >= 2) st_bf16x4(g + (size_t)(row0 + 16 * m + fr) * DFF + j0 + 4 * n, o[m][0], o[m][1], o[m][2], o[m][3]);
                }
                asm volatile("" ::: "memory");
            }
        }
    }
};

__device__ __forceinline__ void ph_mod(KArgs& a, unsigned char* lds, int bid, int nb, int wv) {
    float* mod = (float*)(a.ws + WS_MOD);
    LAS float* red = lptr<float>(lds, 0);
    const int tid = tid_opaque(wv), lane = tid & 63, wave = tid >> 6;
    for (int it = bid; it < 192; it += nb) {
        const int n = it * 64 + lane, l = n / 6144, nn = n % 6144;
        const float* w = a.ada_w + (size_t)l * 1024 * 6144 + nn;
        float acc = 0.f;
        for (int k = wave * 128; k < wave * 128 + 128; ++k) acc += silu_f(a.c[k]) * w[(size_t)k * 6144];
        red[wave * 64 + lane] = acc;
        __syncthreads();
        if (wave == 0) { float s = 0.f;
#pragma unroll
            for (int q = 0; q < 8; ++q) s += red[q * 64 + lane];
            mod[n] = s + a.ada_b[n]; }
        __syncthreads();
    }
    float* rope = (float*)(a.ws + WS_ROPE);
    for (int gid = bid * NT + tid; gid < S * 16; gid += nb * NT) {
        const int t = gid >> 4, i = gid & 15;
        const float ang = (float)t * c_inv_freq[i];
        double rev = (double)ang * 0.15915494309189535;
        rev -= rint(rev);
        const float f = (float)rev;
        rope[gid] = __builtin_amdgcn_cosf(f);
        rope[S * 16 + gid] = __builtin_amdgcn_sinf(f);
    }
}
__device__ __forceinline__ int src_col(int mode, int n, int Nsrc) {
    if (mode == 0) return n < Nsrc ? n : -1;
    if (mode == 1) { const int tile = n >> 8, i = n & 255; return i < 128 ? tile * 128 + i : DFF + tile * 128 + (i - 128); }
    if (mode == 2) { const int h = n / 96, e = n % 96; if (e < 64) return h * 96 + e; const int i = (e - 64) >> 1; return h * 96 + 64 + ((e & 1) ? 16 + i : i); }
    if (mode == 3) { const int h = n >> 6, d = n & 63; return h * 128 + d; }
    { const int h = n >> 6, d = n & 63; return h * 128 + 64 + d; }
}
__device__ __forceinline__ void prep_item(const float* W, int K, int Nsrc, int Npad, int mode, const float* rs1p, const float* rs, const float* cs1p, float cst, bf16_t* dst,
                                          LAS float* scr, int item, int lane) {
    const int nblk = Npad / 32, kb = item / nblk, nbk = item % nblk, k0 = kb * 64, n0 = nbk * 32, nl = lane & 31;
    const int sn = src_col(mode, n0 + nl, Nsrc);
    float cs = cst; if (sn >= 0 && cs1p) cs *= 1.f + cs1p[sn];
#pragma unroll 8
    for (int i = 0; i < 32; ++i) {
        const int kk = 2 * i + (lane >> 5), k = k0 + kk;
        float v = 0.f;
        if (sn >= 0) { v = W[(size_t)k * Nsrc + sn] * cs; if (rs1p) v *= 1.f + rs1p[k]; if (rs) v *= rs[k]; }
        scr[kk * 33 + nl] = v;
    }
    LDS_WAIT();
    const int c = lane & 7;
#pragma unroll
    for (int j = 0; j < 4; ++j) {
        const int n = (lane >> 3) + 8 * j; const LAS float* s = scr + (8 * c) * 33 + n;
        uint4 o; o.x = pk2(s[0 * 33], s[1 * 33]); o.y = pk2(s[2 * 33], s[3 * 33]); o.z = pk2(s[4 * 33], s[5 * 33]); o.w = pk2(s[6 * 33], s[7 * 33]);
        *(uint4*)(dst + (size_t)(n0 + n) * K + k0 + 8 * c) = o;
    }
    LDS_WAIT();
}
__device__ __forceinline__ void bias_item(const float* W, int K, int Nsrc, int mode, const float* shift, float* bias, LAS float* red, int item, int wv) {
    const int tid = tid_opaque(wv), lane = tid & 63, wave = tid >> 6;
    const int n = item * 64 + lane, sn = src_col(mode, n, Nsrc), ks = K / 8;
    float acc = 0.f;
    if (sn >= 0) for (int k = wave * ks; k < wave * ks + ks; ++k) acc += shift[k] * W[(size_t)k * Nsrc + sn];
    red[wave * 64 + lane] = acc;
    __syncthreads();
    if (wave == 0) { float s = 0.f;
#pragma unroll
        for (int q = 0; q < 8; ++q) s += red[q * 64 + lane];
        bias[n] = s; }
    __syncthreads();
}
__device__ __forceinline__ void ph_prep(KArgs& a, unsigned char* lds, int bid, int nb, int wv) {
    const int tid = tid_opaque(wv), lane = tid & 63, wave = tid >> 6;
    unsigned char* ws = a.ws;
    const float* m0 = (const float*)(ws + WS_MOD); const float* m1 = m0 + 6144;
    {
        LAS float* red = lptr<float>(lds, 0);
        for (int it = bid; it < 256; it += nb) {
            int r = it;
            if (r < 60) { bias_item(a.ev_w_in, 1024, EVEN_IN, 0, m0, (float*)(ws + WS_BIAS_IN0), red, r, wv); continue; } r -= 60;
            if (r < 88) { bias_item(a.ffn_w_up, 1024, DFF2, 1, m0 + 3072, (float*)(ws + WS_BIAS_UP0), red, r, wv); continue; } r -= 88;
            if (r < 20) { bias_item(a.od_w_in, 1024, ODD_IN, 0, m1, (float*)(ws + WS_BIAS_IN1), red, r, wv); continue; } r -= 20;
            bias_item(a.ffn_w_up + (size_t)1024 * DFF2, 1024, DFF2, 1, m1 + 3072, (float*)(ws + WS_BIAS_UP1), red, r, wv);
        }
    }
    {
        LAS float* scr = lptr<float>(lds, 4096) + wave * 2176;
        const int gw = bid * 8 + wave, NGW = nb * 8;
        constexpr int I_IN0 = 16 * (EVEN_IN_P / 32), I_SQ = 16 * 32, I_UP = 16 * (DFF2 / 32), I_DN = 44 * 32, I_IN1 = 16 * (ODD_IN_P / 32), I_UQ = 6 * 24, I_UKV = 4 * 16;
        constexpr int NITEMS = I_IN0 + I_SQ + I_UP + I_DN + I_IN1 + I_UQ + 2 * I_UKV + I_SQ + I_UP + I_DN;
        for (int it = gw; it < NITEMS; it += NGW) {
            int r = it;
            if (r < I_IN0) { prep_item(a.ev_w_in, 1024, EVEN_IN, EVEN_IN_P, 0, m0 + 1024, nullptr, nullptr, 1.f, (bf16_t*)(ws + WS_W_IN0), scr, r, lane); continue; } r -= I_IN0;
            if (r < I_SQ) { prep_item(a.ev_w_out, 1024, 1024, 1024, 0, nullptr, nullptr, m0 + 2048, 1.f, (bf16_t*)(ws + WS_W_OUT0), scr, r, lane); continue; } r -= I_SQ;
            if (r < I_UP) { prep_item(a.ffn_w_up, 1024, DFF2, DFF2, 1, m0 + 4096, nullptr, nullptr, 1.f, (bf16_t*)(ws + WS_W_UP0), scr, r, lane); continue; } r -= I_UP;
            if (r < I_DN) { prep_item(a.ffn_w_down, DFF, 1024, 1024, 0, nullptr, nullptr, m0 + 5120, 1.f, (bf16_t*)(ws + WS_W_DN0), scr, r, lane); continue; } r -= I_DN;
            if (r < I_IN1) { prep_item(a.od_w_in, 1024, ODD_IN, ODD_IN_P, 0, m1 + 1024, nullptr, nullptr, 1.f, (bf16_t*)(ws + WS_W_IN1), scr, r, lane); continue; } r -= I_IN1;
            if (r < I_UQ) { prep_item(a.w_uq, 384, 768, 768, 2, nullptr, a.q_norm_g, nullptr, MLA_QSCALE, (bf16_t*)(ws + WS_W_UQ), scr, r, lane); continue; } r -= I_UQ;
            if (r < I_UKV) { prep_item(a.w_ukv, 256, 1024, 512, 3, nullptr, a.kv_norm_g, nullptr, 1.f, (bf16_t*)(ws + WS_W_UK), scr, r, lane); continue; } r -= I_UKV;
            if (r < I_UKV) { prep_item(a.w_ukv, 256, 1024, 512, 4, nullptr, a.kv_norm_g, nullptr, 1.f, (bf16_t*)(ws + WS_W_UV), scr, r, lane); continue; } r -= I_UKV;
            if (r < I_SQ) { prep_item(a.od_w_out, 1024, 1024, 1024, 0, nullptr, nullptr, m1 + 2048, 1.f, (bf16_t*)(ws + WS_W_OUT1), scr, r, lane); continue; } r -= I_SQ;
            if (r < I_UP) { prep_item(a.ffn_w_up + (size_t)1024 * DFF2, 1024, DFF2, DFF2, 1, m1 + 4096, nullptr, nullptr, 1.f, (bf16_t*)(ws + WS_W_UP1), scr, r, lane); continue; } r -= I_UP;
            prep_item(a.ffn_w_down + (size_t)DFF * 1024, DFF, 1024, 1024, 0, nullptr, nullptr, m1 + 5120, 1.f, (bf16_t*)(ws + WS_W_DN1), scr, r, lane);
        }
    }
    {
        bf16_t* dst = (bf16_t*)(ws + WS_W_POOL);
        for (int gid = bid * NT + tid; gid < 512 * 512; gid += nb * NT) {
            const int n = gid >> 9, k = gid & 511, g = n >> 7, d = n & 127;
            float v = 0.f;
            if ((k >> 7) == g) v = a.pool_w[((size_t)g * 128 + (k & 127)) * 128 + d] * a.pool_scale[n];
            dst[gid] = f2bf(v);
        }
    }
    {
        bf16_t* xb = (bf16_t*)(ws + WS_XB);
        for (int gid = bid * NT + tid; gid < S * D / 4; gid += nb * NT) {
            const float4 v = ((const float4*)a.x)[gid];
            st_bf16x4(xb + (size_t)gid * 4, v.x, v.y, v.z, v.w);
        }
    }
}
__device__ __forceinline__ void ph_ln(float* pre, const float* g, const float* b, bf16_t* xb, int bid, int nb, int wv) {
    const int lane = tid_opaque(wv) & 63, wave = tid_opaque(wv) >> 6;
    for (int row = bid * 8 + wave; row < S; row += nb * 8) {
        float4* xr = (float4*)(pre + (size_t)row * D) + lane;
        float4 v[4]; float s = 0.f;
#pragma unroll
        for (int j = 0; j < 4; ++j) { v[j] = xr[64 * j]; s += (v[j].x + v[j].y) + (v[j].z + v[j].w); }
        const float mean = wave_sum(s) * (1.f / D); float s2 = 0.f;
#pragma unroll
        for (int j = 0; j < 4; ++j) { v[j].x -= mean; v[j].y -= mean; v[j].z -= mean; v[j].w -= mean; s2 += (v[j].x * v[j].x + v[j].y * v[j].y) + (v[j].z * v[j].z + v[j].w * v[j].w); }
        const float rstd = 1.f / sqrtf(wave_sum(s2) * (1.f / D) + LN_EPS);
#pragma unroll
        for (int j = 0; j < 4; ++j) {
            const float4 gg = ((const float4*)g)[64 * j + lane], bb = ((const float4*)b)[64 * j + lane];
            float4 o; o.x = v[j].x * rstd * gg.x + bb.x; o.y = v[j].y * rstd * gg.y + bb.y; o.z = v[j].z * rstd * gg.z + bb.z; o.w = v[j].w * rstd * gg.w + bb.w;
            xr[64 * j] = o;
            st_bf16x4(xb + (size_t)row * D + (64 * j + lane) * 4, o.x, o.y, o.z, o.w);
        }
    }
}
__device__ __forceinline__ void ph_shortconv(KArgs& a, int bid, int nb, int wv) {
    const bf16_t* bg = (const bf16_t*)(a.ws + WS_BG); const bf16_t* cg = (const bf16_t*)(a.ws + WS_CG); const bf16_t* xc = (const bf16_t*)(a.ws + WS_XC);
    bf16_t* y = (bf16_t*)(a.ws + WS_Y0);
    for (int gid = bid * NT + tid_opaque(wv); gid < S * 64; gid += nb * NT) {
        const int t = gid >> 6, c0 = (gid & 63) * 8;
        float acc[8];
#pragma unroll
        for (int e = 0; e < 8; ++e) acc[e] = 0.f;
#pragma unroll
        for (int kk = 0; kk < 3; ++kk) {
            const int tt = t - 2 + kk;
            if (tt >= 0) {
                const uint4 cgv = *(const uint4*)(cg + (size_t)tt * 512 + c0), xv = *(const uint4*)(xc + (size_t)tt * 512 + c0);
                const float4 w0 = *(const float4*)(a.ev_conv_w + kk * 512 + c0), w1 = *(const float4*)(a.ev_conv_w + kk * 512 + c0 + 4);
                acc[0] += w0.x * bflo(cgv.x) * bflo(xv.x); acc[1] += w0.y * bfhi(cgv.x) * bfhi(xv.x);
                acc[2] += w0.z * bflo(cgv.y) * bflo(xv.y); acc[3] += w0.w * bfhi(cgv.y) * bfhi(xv.y);
                acc[4] += w1.x * bflo(cgv.z) * bflo(xv.z); acc[5] += w1.y * bfhi(cgv.z) * bfhi(xv.z);
                acc[6] += w1.z * bflo(cgv.w) * bflo(xv.w); acc[7] += w1.w * bfhi(cgv.w) * bfhi(xv.w);
            }
        }
        const uint4 b = *(const uint4*)(bg + (size_t)t * 512 + c0);
        uint4 o; o.x = pk2(bflo(b.x) * acc[0], bfhi(b.x) * acc[1]); o.y = pk2(bflo(b.y) * acc[2], bfhi(b.y) * acc[3]);
        o.z = pk2(bflo(b.z) * acc[4], bfhi(b.z) * acc[5]); o.w = pk2(bflo(b.w) * acc[6], bfhi(b.w) * acc[7]);
        *(uint4*)(y + (size_t)t * 1024 + 512 + c0) = o;
    }
}
__device__ __forceinline__ void nv_topk(KArgs& a, unsigned char* lds, int t, int wv) {
    const f16_t* qi = (const f16_t*)(a.ws + WS_QI); const f16_t* ki = (const f16_t*)(a.ws + WS_KI); const float* wi = (const float*)(a.ws + WS_WI);
    unsigned short* out = (unsigned short*)(a.ws + WS_IDX) + (size_t)t * TOPK;
    LAS unsigned* key = lptr<unsigned>(lds, 0);
    LAS float* qs = lptr<float>(lds, 65536);
    LAS unsigned* sc = lptr<unsigned>(lds, 65536 + 2048);
    const int tid = tid_opaque(wv), lane = tid & 63, wq = tid >> 6, N = (t / 64 + 1) * 64;
    if (N <= TOPK) { if (tid < N) out[tid] = (unsigned short)tid; return; }
    qs[tid] = (float)qi[(size_t)t * 512 + tid];
    float w[8];
#pragma unroll
    for (int h = 0; h < 8; ++h) w[h] = wi[(size_t)t * 8 + h];
    __syncthreads();
    for (int s = tid; s < N; s += NT) {
        asm volatile("" ::: "memory");
        const uint4* kp = (const uint4*)(ki + (size_t)s * 64);
        uint4 kq[8];
#pragma unroll
        for (int j = 0; j < 8; ++j) kq[j] = kp[j];
        float score = 0.f;
#pragma unroll
        for (int h = 0; h < 8; ++h) {
            float d = 0.f;
#pragma unroll
            for (int j = 0; j < 8; ++j) { const LAS float* q = qs + h * 64 + j * 8; const uint4 u = kq[j];
                d += q[0] * h2f_lo(u.x) + q[1] * h2f_hi(u.x) + q[2] * h2f_lo(u.y) + q[3] * h2f_hi(u.y) + q[4] * h2f_lo(u.z) + q[5] * h2f_hi(u.z) + q[6] * h2f_lo(u.w) + q[7] * h2f_hi(u.w); }
            score += w[h] * fmaxf(d, 0.f);
        }
        unsigned u = __float_as_uint(score); u = (u & 0x80000000u) ? ~u : (u | 0x80000000u);
        key[s] = u;
    }
    __syncthreads();
    unsigned T = 0;
    for (int bit = 31; bit >= 0; --bit) {
        const unsigned cand = T | (1u << bit);
        if (tid == 0) sc[0] = 0;
        __syncthreads();
        unsigned c = 0;
        for (int s = tid; s < N; s += NT) c += (key[s] >= cand) ? 1u : 0u;
        __hip_atomic_fetch_add(&sc[0], c, __ATOMIC_RELAXED, __HIP_MEMORY_SCOPE_WORKGROUP);
        __syncthreads();
        if (sc[0] >= (unsigned)TOPK) T = cand;
        __syncthreads();
    }
    if (tid == 0) sc[0] = 0;
    __syncthreads();
    for (int s = tid; s < N; s += NT) if (key[s] > T) { const unsigned p = __hip_atomic_fetch_add(&sc[0], 1u, __ATOMIC_RELAXED, __HIP_MEMORY_SCOPE_WORKGROUP); out[p] = (unsigned short)s; }
    __syncthreads();
    const unsigned ngt = sc[0], need = TOPK - ngt;
    __syncthreads();
    unsigned base = 0;
    for (int s0 = 0; s0 < N; s0 += NT) {
        const int s = s0 + tid;
        const bool eq = (s < N) && (key[s] == T);
        const unsigned long long m = __ballot(eq);
        if (lane == 0) sc[1 + wq] = (unsigned)__popcll(m);
        __syncthreads();
        unsigned r = base, tot = 0;
#pragma unroll
        for (int q = 0; q < 8; ++q) { const unsigned cq = sc[1 + q]; if (q < wq) r += cq; tot += cq; }
        r += (unsigned)__popcll(m & ((1ull << lane) - 1ull));
        if (eq && r < need) out[ngt + r] = (unsigned short)s;
        base += tot;
        __syncthreads();
    }
}
__device__ __forceinline__ void nv_dsa_attn(KArgs& a, unsigned char* lds, int t, int wv) {
    const bf16_t* q = (const bf16_t*)(a.ws + WS_Q0); const bf16_t* k = (const bf16_t*)(a.ws + WS_K0); const bf16_t* v = (const bf16_t*)(a.ws + WS_V0);
    const unsigned short* idx = (const unsigned short*)(a.ws + WS_IDX); bf16_t* y = (bf16_t*)(a.ws + WS_Y0);
    LAS float* p = lptr<float>(lds, 72 * 1024);
    LAS float* qs = lptr<float>(lds, 80 * 1024);
    LAS int* sid = lptr<int>(lds, 82 * 1024);
    LAS float* red = lptr<float>(lds, 83 * 1024);
    const int tid = tid_opaque(wv);
    const int N = (t / 64 + 1) * 64, cnt = N < TOPK ? N : TOPK;
    qs[tid] = bf2f(q[(size_t)t * 512 + tid]);
    int id = 0;
    if (tid < 256) { id = tid < cnt ? (int)idx[(size_t)t * TOPK + tid] : 0; sid[tid] = id; }
    __syncthreads();
    if (tid < cnt) {
        const float dist = fabsf((float)(t - id));
        const uint4* kp = (const uint4*)(k + (size_t)id * 512);
#pragma unroll
        for (int h = 0; h < 8; ++h) {
            float d = 0.f;
#pragma unroll
            for (int j = 0; j < 8; ++j) d += dot8q(qs + h * 64 + j * 8, kp[h * 8 + j]);
            p[h * 256 + tid] = d - exp2f(-(float)(h + 1)) * dist;
        }
    }
    __syncthreads();
    if (tid < 8) {
        float m = -3.0e38f;
        for (int j = 0; j < cnt; ++j) m = fmaxf(m, p[tid * 256 + j]);
        float s = 0.f;
        for (int j = 0; j < cnt; ++j) s += __expf(p[tid * 256 + j] - m);
        red[tid * 2] = m; red[tid * 2 + 1] = 1.f / s;
    }
    __syncthreads();
    if (tid < cnt) {
#pragma unroll
        for (int h = 0; h < 8; ++h) p[h * 256 + tid] = __expf(p[h * 256 + tid] - red[h * 2]) * red[h * 2 + 1];
    }
    __syncthreads();
    {
        const int c = tid, h = c >> 6;
        float acc = 0.f;
        for (int j = 0; j < cnt; ++j) acc += p[h * 256 + j] * bf2f(v[(size_t)sid[j] * 512 + c]);
        y[(size_t)t * 1024 + c] = f2bf(acc);
    }
}
__device__ __forceinline__ void ph_ffn_fix(const bf16_t* hu, const float* cw, bf16_t* g, int bid, int nb, int wv) {
    for (int gid = bid * NT + tid_opaque(wv); gid < 256 * 2 * DFF; gid += nb * NT) {
        const int j = gid % DFF, br = gid / DFF, rho = br & 1, blk = br >> 1, t = blk * 64 + rho;
        const int nv = 256 * (j >> 7) + (j & 127), ng = nv + 128;
        const bf16_t* cur = hu + (size_t)blk * 4 * DFF2; const bf16_t* prv = hu + (size_t)(blk > 0 ? blk - 1 : 0) * 4 * DFF2;
        const float u0v = bf2f(cur[rho * DFF2 + nv]), u0g = bf2f(cur[rho * DFF2 + ng]);
        float u1v, u1g, u2v, u2g;
        if (rho == 0) { u1v = blk > 0 ? bf2f(prv[3 * DFF2 + nv]) : 0.f; u1g = blk > 0 ? bf2f(prv[3 * DFF2 + ng]) : 0.f; u2v = blk > 0 ? bf2f(prv[2 * DFF2 + nv]) : 0.f; u2g = blk > 0 ? bf2f(prv[2 * DFF2 + ng]) : 0.f; }
        else          { u1v = bf2f(cur[nv]); u1g = bf2f(cur[ng]); u2v = blk > 0 ? bf2f(prv[3 * DFF2 + nv]) : 0.f; u2g = blk > 0 ? bf2f(prv[3 * DFF2 + ng]) : 0.f; }
        const float val = cw[j] * u2v + cw[DFF2 + j] * u1v + cw[2 * DFF2 + j] * u0v;
        const float gat = cw[DFF + j] * u2g + cw[DFF2 + DFF + j] * u1g + cw[2 * DFF2 + DFF + j] * u0g;
        g[(size_t)t * DFF + j] = f2bf(silu_f(gat) * val);
    }
}
__device__ __forceinline__ void nv_ffn_up(const bf16_t* xb, const bf16_t* wup, const float* bias, const float* cw, bf16_t* g, int bid, int nb, int wv) {
    const int vb = tid_opaque(wv) >> 8, tl = tid_opaque(wv) & 255;
    for (int it = bid * 2 + vb; it < 11 * (S / 8); it += nb * 2) {
        const int j = (it % 11) * 256 + tl, t0 = (it / 11) * 8;
        const int nv = 256 * (j >> 7) + (j & 127), ng = nv + 128;
        float uv[10], ug[10];
#pragma unroll
        for (int i = 0; i < 10; ++i) { uv[i] = 0.f; ug[i] = 0.f; }
        const bf16_t* wv = wup + (size_t)nv * D; const bf16_t* wg = wup + (size_t)ng * D;
        for (int k = 0; k < D; k += 8) {
            const uint4 av = *(const uint4*)(wv + k), bv = *(const uint4*)(wg + k);
#pragma unroll
            for (int i = 0; i < 10; ++i) {
                int r = t0 - 2 + i; if (r < 0) r = 0;
                const uint4 x = *(const uint4*)(xb + (size_t)r * D + k);
                uv[i] += dot8(x, av); ug[i] += dot8(x, bv);
            }
        }
        const float bvv = bias[nv], bgt = bias[ng];
#pragma unroll
        for (int i = 0; i < 10; ++i) { const bool ok = (t0 - 2 + i) >= 0; uv[i] = ok ? uv[i] + bvv : 0.f; ug[i] = ok ? ug[i] + bgt : 0.f; }
        const float cv0 = cw[j], cv1 = cw[DFF2 + j], cv2 = cw[2 * DFF2 + j];
        const float cg0 = cw[DFF + j], cg1 = cw[DFF2 + DFF + j], cg2 = cw[2 * DFF2 + DFF + j];
#pragma unroll
        for (int i = 0; i < 8; ++i) {
            const float val = cv0 * uv[i] + cv1 * uv[i + 1] + cv2 * uv[i + 2];
            const float gat = cg0 * ug[i] + cg1 * ug[i + 1] + cg2 * ug[i + 2];
            g[(size_t)(t0 + i) * DFF + j] = f2bf(silu_f(gat) * val);
        }
    }
}
__device__ __forceinline__ void ph_l1_prep(KArgs& a, int bid, int nb, int wv) {
    const bf16_t* z1 = (const bf16_t*)(a.ws + WS_Z1); const float* rope = (const float*)(a.ws + WS_ROPE);
    bf16_t* pl = (bf16_t*)(a.ws + WS_PL); float* rs = (float*)(a.ws + WS_RS); bf16_t* kr = (bf16_t*)(a.ws + WS_KR);
    const int lane = tid_opaque(wv) & 63, wave = tid_opaque(wv) >> 6;
    for (int t = bid * 8 + wave; t < S; t += nb * 8) {
        const bf16_t* zr = z1 + (size_t)t * ODD_IN_P;
        {
            const int c0 = lane * 8, win = 2 << (lane >> 4);
            const int lo = (t + 1 - win) > 0 ? (t + 1 - win) : 0;
            float sm[8];
#pragma unroll
            for (int e = 0; e < 8; ++e) sm[e] = 0.f;
            for (int r = lo; r <= t; ++r) {
                const uint4 u = *(const uint4*)(z1 + (size_t)r * ODD_IN_P + c0);
                sm[0] += bflo(u.x); sm[1] += bfhi(u.x); sm[2] += bflo(u.y); sm[3] += bfhi(u.y); sm[4] += bflo(u.z); sm[5] += bfhi(u.z); sm[6] += bflo(u.w); sm[7] += bfhi(u.w);
            }
            const float ic = 1.f / (float)(t + 1 - lo);
            const uint4 u = *(const uint4*)(zr + c0);
            uint4 o; o.x = pk2(sm[0] * ic - bflo(u.x), sm[1] * ic - bfhi(u.x)); o.y = pk2(sm[2] * ic - bflo(u.y), sm[3] * ic - bfhi(u.y));
            o.z = pk2(sm[4] * ic - bflo(u.z), sm[5] * ic - bfhi(u.z)); o.w = pk2(sm[6] * ic - bflo(u.w), sm[7] * ic - bfhi(u.w));
            *(uint4*)(pl + (size_t)t * 512 + c0) = o;
        }
        {
            float sq = 0.f;
#pragma unroll
            for (int j = 0; j < 3; ++j) { const unsigned u = *(const unsigned*)(zr + 512 + 128 * j + lane * 2); sq += bflo(u) * bflo(u) + bfhi(u) * bfhi(u); }
            sq = wave_sum(sq);
            const uint2 u2 = *(const uint2*)(zr + 896 + lane * 4);
            float sk = bflo(u2.x) * bflo(u2.x) + bfhi(u2.x) * bfhi(u2.x) + bflo(u2.y) * bflo(u2.y) + bfhi(u2.y) * bfhi(u2.y);
            sk = wave_sum(sk);
            if (lane == 0) { rs[(size_t)t * 2] = 1.f / sqrtf(sq * (1.f / 384.f) + RMS_EPS); rs[(size_t)t * 2 + 1] = 1.f / sqrtf(sk * (1.f / 256.f) + RMS_EPS); }
        }
        if (lane < 16) {
            const float x1 = bf2f(zr[1152 + lane]), x2 = bf2f(zr[1168 + lane]);
            const float c = rope[(size_t)t * 16 + lane], s = rope[(size_t)S * 16 + (size_t)t * 16 + lane];
            *(unsigned*)(kr + (size_t)t * 32 + 2 * lane) = pk2(x1 * c - x2 * s, x2 * c + x1 * s);
        }
    }
}
__device__ __forceinline__ void nv_mla(KArgs& a, unsigned char* lds, int t, int h, int wv) {
    const bf16_t* q1 = (const bf16_t*)(a.ws + WS_Q1); const bf16_t* k1 = (const bf16_t*)(a.ws + WS_K1); const bf16_t* kr = (const bf16_t*)(a.ws + WS_KR);
    const bf16_t* vt = (const bf16_t*)(a.ws + WS_VT); bf16_t* y = (bf16_t*)(a.ws + WS_Y1);
    LAS float* lg = lptr<float>(lds, 0);
    LAS float* qs = lptr<float>(lds, 65536);
    LAS float* red = lptr<float>(lds, 65536 + 512);
    const int tid = tid_opaque(wv), lane = tid & 63, wq = tid >> 6;
    const int N = (t / 64 + 1) * 64;
    if (tid < 96) qs[tid] = bf2f(q1[(size_t)t * 768 + h * 96 + tid]);
    __syncthreads();
    float m = -3.0e38f;
    for (int s = tid; s < N; s += NT) {
        asm volatile("" ::: "memory");
        const uint4* kp = (const uint4*)(k1 + (size_t)s * 512 + h * 64);
        float d = 0.f;
#pragma unroll
        for (int j = 0; j < 8; ++j) d += dot8q(qs + j * 8, kp[j]);
        const uint4* rp = (const uint4*)(kr + (size_t)s * 32);
#pragma unroll
        for (int j = 0; j < 4; ++j) d += dot8q(qs + 64 + j * 8, rp[j]);
        lg[s] = d; m = fmaxf(m, d);
    }
    m = wave_max(m);
    if (lane == 0) red[wq] = m;
    __syncthreads();
    m = red[0];
#pragma unroll
    for (int q = 1; q < 8; ++q) m = fmaxf(m, red[q]);
    __syncthreads();
    float sum = 0.f;
    for (int s = tid; s < N; s += NT) { const float pp = exp2f(lg[s] - m); lg[s] = pp; sum += pp; }
    sum = wave_sum(sum);
    if (lane == 0) red[wq] = sum;
    __syncthreads();
    float tot = 0.f;
#pragma unroll
    for (int q = 0; q < 8; ++q) tot += red[q];
    const float inv = 1.f / tot;
    for (int dd = 0; dd < 8; ++dd) {
        const int d = wq * 8 + dd;
        const bf16_t* vp = vt + (size_t)(h * 64 + d) * S;
        float acc = 0.f;
        for (int s = lane; s < N; s += 64) acc += lg[s] * bf2f(vp[s]);
        acc = wave_sum(acc);
        if (lane == 0) y[(size_t)t * 1024 + 512 + h * 64 + d] = f2bf(acc * inv);
    }
    __syncthreads();
}

constexpr int N_PHASES = 20;
__global__ void __launch_bounds__(NT, 2) mega(Args  ) {
    extern __shared__ __attribute__((aligned(16))) unsigned char lds[];
    const int wv = __builtin_amdgcn_readfirstlane((int)threadIdx.x >> 6);
    const int tid = tid_opaque(wv), bid = blockIdx.x, nb = gridDim.x;
    for (int u = tid; u < (LDS_BYTES - LDSCTL_OFF) / 4; u += NT) ((LAS unsigned*)((LAS unsigned char*)lds + LDSCTL_OFF))[u] = 0u;
    __syncthreads();
    volatile LAS unsigned* MISC = (volatile LAS unsigned*)((LAS unsigned char*)lds + MISC_OFF);
    const int ph_lo = kargs().ph_lo, ph_hi = kargs().ph_hi;
    XcdBarrier bar = xcd_barrier_post((unsigned*)(kargs().ws + WS_CTL) + CW_BAR, MISC + 8, wv);
#define IN(k) (ph_lo <= (k) && (k) < ph_hi)
#define SEAM(k) do { if (ph_lo <= (k) && (k) + 1 < ph_hi) xcd_barrier(bar); } while (0)
#define WSP(T, off) ((T*)(ws + (off)))

    if (IN(0)) { KArgs& a = kargs(); ph_mod(a, lds, bid, nb, wv); }
    SEAM(0);
    if (IN(1)) { KArgs& a = kargs(); ph_prep(a, lds, bid, nb, wv); }
    SEAM(1);
    if (IN(2)) { KArgs& a = kargs(); unsigned char* ws = a.ws;
        run_gemm(lds, WSP(const bf16_t, WS_XB), D, WSP(const bf16_t, WS_W_IN0), D, S, EVEN_IN_P, D,
                 EpiIn0{WSP(const float, WS_BIAS_IN0), WSP(bf16_t, WS_Q0), WSP(bf16_t, WS_K0), WSP(bf16_t, WS_V0), WSP(bf16_t, WS_BG), WSP(bf16_t, WS_CG), WSP(bf16_t, WS_XC),
                        WSP(f16_t, WS_QI), WSP(f16_t, WS_KI), WSP(float, WS_WI)}, nb, bid, wv); }
    SEAM(2);
    if (IN(3)) { KArgs& a = kargs();
        ph_shortconv(a, bid, nb, wv);
        for (int t = bid; t < S; t += nb) { nv_topk(a, lds, t, wv); __syncthreads(); nv_dsa_attn(a, lds, t, wv); __syncthreads(); }
    }
    SEAM(3);
    if (IN(4)) { KArgs& a = kargs(); unsigned char* ws = a.ws;
        run_gemm(lds, WSP(const bf16_t, WS_Y0), D, WSP(const bf16_t, WS_W_OUT0), D, S, D, D, EpiResid{a.x, a.out}, nb, bid, wv); }
    SEAM(4);
    if (IN(5)) { KArgs& a = kargs(); ph_ln(a.out, a.ln_mix_g, a.ln_mix_b, (bf16_t*)(a.ws + WS_XB), bid, nb, wv); }
    SEAM(5);
    if (IN(6)) { KArgs& a = kargs(); unsigned char* ws = a.ws;
        run_gemm_epi(lds, WSP(const bf16_t, WS_XB), D, WSP(const bf16_t, WS_W_UP0), D, S, DFF2, D, EpiFfnUp{WSP(const float, WS_BIAS_UP0), a.ffn_conv_w, WSP(bf16_t, WS_G), WSP(bf16_t, WS_HU)}, nb, bid, wv); }
    SEAM(6);
    if (IN(7)) { KArgs& a = kargs(); unsigned char* ws = a.ws; ph_ffn_fix(WSP(const bf16_t, WS_HU), a.ffn_conv_w, WSP(bf16_t, WS_G), bid, nb, wv); }
    SEAM(7);
    if (IN(8)) { KArgs& a = kargs(); unsigned char* ws = a.ws;
        run_gemm(lds, WSP(const bf16_t, WS_G), DFF, WSP(const bf16_t, WS_W_DN0), DFF, S, D, DFF, EpiResid{a.out, a.out}, nb, bid, wv); }
    SEAM(8);
    if (IN(9)) { KArgs& a = kargs(); ph_ln(a.out, a.ln_ffn_g, a.ln_ffn_b, (bf16_t*)(a.ws + WS_XB), bid, nb, wv); }
    SEAM(9);
    if (IN(10)) { KArgs& a = kargs(); unsigned char* ws = a.ws;
        run_gemm(lds, WSP(const bf16_t, WS_XB), D, WSP(const bf16_t, WS_W_IN1), D, S, ODD_IN_P, D, EpiBiasBf16{WSP(const float, WS_BIAS_IN1), WSP(bf16_t, WS_Z1), ODD_IN_P}, nb, bid, wv); }
    SEAM(10);
    if (IN(11)) { KArgs& a = kargs(); ph_l1_prep(a, bid, nb, wv); }
    SEAM(11);
    if (IN(12)) {
        { KArgs& a = kargs(); unsigned char* ws = a.ws;
          run_gemm(lds, WSP(const bf16_t, WS_PL), 512, WSP(const bf16_t, WS_W_POOL), 512, S, 512, 512, EpiPlainBf16{WSP(bf16_t, WS_Y1), 1024}, nb, bid, wv); }
        { KArgs& a = kargs(); unsigned char* ws = a.ws;
          run_gemm(lds, WSP(const bf16_t, WS_Z1) + 512, ODD_IN_P, WSP(const bf16_t, WS_W_UQ), 384, S, 768, 384, EpiQ1{WSP(const float, WS_RS), WSP(const float, WS_ROPE), WSP(bf16_t, WS_Q1)}, nb, bid, wv); }
        { KArgs& a = kargs(); unsigned char* ws = a.ws;
          run_gemm(lds, WSP(const bf16_t, WS_Z1) + 896, ODD_IN_P, WSP(const bf16_t, WS_W_UK), 256, S, 512, 256, EpiRowScaleBf16{WSP(const float, WS_RS), 1, WSP(bf16_t, WS_K1), 512}, nb, bid, wv); }
        { KArgs& a = kargs(); unsigned char* ws = a.ws;
          run_gemm(lds, WSP(const bf16_t, WS_W_UV), 256, WSP(const bf16_t, WS_Z1) + 896, ODD_IN_P, 512, S, 256, EpiColScaleBf16{WSP(const float, WS_RS), 1, WSP(bf16_t, WS_VT), S}, nb, bid, wv); }
    }
    SEAM(12);
    if (IN(13)) { KArgs& a = kargs(); for (int it = bid; it < S * 8; it += nb) nv_mla(a, lds, it >> 3, it & 7, wv); }
    SEAM(13);
    if (IN(14)) { KArgs& a = kargs(); unsigned char* ws = a.ws;
        run_gemm(lds, WSP(const bf16_t, WS_Y1), D, WSP(const bf16_t, WS_W_OUT1), D, S, D, D, EpiResid{a.out, a.out}, nb, bid, wv); }
    SEAM(14);
    if (IN(15)) { KArgs& a = kargs(); ph_ln(a.out, a.ln_mix_g + D, a.ln_mix_b + D, (bf16_t*)(a.ws + WS_XB), bid, nb, wv); }
    SEAM(15);
    if (IN(16)) { KArgs& a = kargs(); unsigned char* ws = a.ws;
        run_gemm_epi(lds, WSP(const bf16_t, WS_XB), D, WSP(const bf16_t, WS_W_UP1), D, S, DFF2, D, EpiFfnUp{WSP(const float, WS_BIAS_UP1), a.ffn_conv_w + (size_t)3 * DFF2, WSP(bf16_t, WS_G), WSP(bf16_t, WS_HU)}, nb, bid, wv); }
    SEAM(16);
    if (IN(17)) { KArgs& a = kargs(); unsigned char* ws = a.ws; ph_ffn_fix(WSP(const bf16_t, WS_HU), a.ffn_conv_w + (size_t)3 * DFF2, WSP(bf16_t, WS_G), bid, nb, wv); }
    SEAM(17);
    if (IN(18)) { KArgs& a = kargs(); unsigned char* ws = a.ws;
        run_gemm(lds, WSP(const bf16_t, WS_G), DFF, WSP(const bf16_t, WS_W_DN1), DFF, S, D, DFF, EpiResid{a.out, a.out}, nb, bid, wv); }
    SEAM(18);
    if (IN(19)) { KArgs& a = kargs(); ph_ln(a.out, a.ln_ffn_g + D, a.ln_ffn_b + D, (bf16_t*)(a.ws + WS_XB), bid, nb, wv); }
#undef IN
#undef SEAM
#undef WSP
}

extern "C" void kernel_launch(void* const* d_in, const int* in_sizes, int n_in, void* d_out, int out_size, void* d_ws, size_t ws_size, hipStream_t stream) {
    static int grid = 0;
    if (grid == 0) {
        if (n_in != 22 || out_size != S * D || ws_size < WS_END) { fprintf(stderr, "kernel_launch: unexpected problem (n_in %d out %d ws %zu)\n", n_in, out_size, ws_size); grid = -1; return; }
        int dev = 0, cus = 0;
        if (hipGetDevice(&dev) != hipSuccess || hipDeviceGetAttribute(&cus, hipDeviceAttributeMultiprocessorCount, dev) != hipSuccess) { grid = -1; return; }
        if (hipFuncSetAttribute((const void*)mega, hipFuncAttributeMaxDynamicSharedMemorySize, LDS_BYTES) != hipSuccess) { fprintf(stderr, "kernel_launch: hipFuncSetAttribute failed\n"); grid = -1; return; }
        grid = cus;
    }
    if (grid < 0) return;
    if (hipMemsetAsync((char*)d_ws + WS_CTL, 0, CTL_ZERO_BYTES, stream) != hipSuccess) return;
    Args a{};
    const float** ap = (const float**)&a;
    for (int i = 0; i < 22; ++i) ap[i] = (const float*)d_in[i];
    a.out = (float*)d_out; a.ws = (unsigned char*)d_ws;
#if MK_SPLIT
    for (int p = 0; p < N_PHASES; ++p) { a.ph_lo = p; a.ph_hi = p + 1; hipLaunchKernelGGL(mega, dim3(grid), dim3(NT), LDS_BYTES, stream, a); }
#else
    a.ph_lo = 0; a.ph_hi = N_PHASES;
    hipLaunchKernelGGL(mega, dim3(grid), dim3(NT), LDS_BYTES, stream, a);
#endif
}
```

```cpp
#include <hip/hip_runtime.h>
#include <cstdint>
#include <cstdio>

typedef unsigned short bf16_t;
typedef _Float16 f16_t;

#ifndef MK_SPLIT
#define MK_SPLIT 0
#endif

constexpr int S = 16384, D = 1024;
constexpr int EVEN_IN = 3656, EVEN_IN_P = 3840;
constexpr int ODD_IN = 1184, ODD_IN_P = 1280;
constexpr int DFF = 2816, DFF2 = 5632;
constexpr int TOPK = 256;
constexpr float DN_ALPHA = 1.41421356237309515f;
constexpr float LN_EPS = 1e-5f, RMS_EPS = 1e-6f;
constexpr float MLA_QSCALE = 0.14724444602590306f;
constexpr int NT = 512;

constexpr size_t MiB = 1u << 20;
constexpr size_t WS_CTL = 0, CTL_ZERO_BYTES = 1 * MiB;
constexpr size_t WS_MOD = 1 * MiB;
constexpr size_t WS_BIAS_IN0 = 1 * MiB + 64 * 1024;
constexpr size_t WS_BIAS_UP0 = 1 * MiB + 96 * 1024;
constexpr size_t WS_BIAS_IN1 = 1 * MiB + 128 * 1024;
constexpr size_t WS_BIAS_UP1 = 1 * MiB + 160 * 1024;
constexpr size_t WS_RS = 1 * MiB + 256 * 1024;
constexpr size_t WS_ROPE = 2 * MiB;
constexpr size_t WS_W_IN0 = 4 * MiB;
constexpr size_t WS_W_OUT0 = 12 * MiB;
constexpr size_t WS_W_UP0 = 14 * MiB;
constexpr size_t WS_W_DN0 = 25 * MiB;
constexpr size_t WS_W_IN1 = 31 * MiB;
constexpr size_t WS_W_POOL = 34 * MiB;
constexpr size_t WS_W_UQ = 35 * MiB;
constexpr size_t WS_W_UK = 36 * MiB;
constexpr size_t WS_W_UV = 36 * MiB + 512 * 1024;
constexpr size_t WS_W_OUT1 = 37 * MiB;
constexpr size_t WS_W_UP1 = 39 * MiB;
constexpr size_t WS_W_DN1 = 50 * MiB;
constexpr size_t WS_XB = 56 * MiB;
constexpr size_t WS_Q0 = 88 * MiB, WS_K0 = 104 * MiB, WS_V0 = 120 * MiB;
constexpr size_t WS_QI = 136 * MiB;
constexpr size_t WS_BG = 152 * MiB, WS_CG = 168 * MiB, WS_XC = 184 * MiB;
constexpr size_t WS_KI = 200 * MiB;
constexpr size_t WS_WI = 202 * MiB;
constexpr size_t WS_IDX = 203 * MiB;
constexpr size_t WS_Y0 = 212 * MiB;
constexpr size_t WS_G = 88 * MiB;
constexpr size_t WS_HU = 176 * MiB;
constexpr size_t WS_Z1 = 88 * MiB;
constexpr size_t WS_PL = 128 * MiB;
constexpr size_t WS_Q1 = 144 * MiB;
constexpr size_t WS_K1 = 168 * MiB;
constexpr size_t WS_KR = 184 * MiB;
constexpr size_t WS_VT = 186 * MiB;
constexpr size_t WS_Y1 = 202 * MiB;
constexpr size_t WS_END = 256 * MiB;

constexpr int CW_BAR = 4096;

constexpr int RING_BYTES = 131072;
constexpr int LDSCTL_OFF = RING_BYTES, MISC_OFF = LDSCTL_OFF + 320;
constexpr int LDS_BYTES = 147456;

#define GAS __attribute__((address_space(1)))
#define LAS __attribute__((address_space(3)))
typedef GAS unsigned gu32;
#define LDS_WAIT() asm volatile("s_waitcnt lgkmcnt(0)" ::: "memory")
__device__ __forceinline__ float bf2f(bf16_t h) { return __uint_as_float(((unsigned)h) << 16); }
__device__ __forceinline__ bf16_t f2bf(float f) { unsigned u = __float_as_uint(f); return (bf16_t)((u + 0x7fffu + ((u >> 16) & 1u)) >> 16); }
__device__ __forceinline__ unsigned pk2(float lo, float hi) { return (unsigned)f2bf(lo) | ((unsigned)f2bf(hi) << 16); }
__device__ __forceinline__ float bflo(unsigned w) { return __uint_as_float(w << 16); }
__device__ __forceinline__ float bfhi(unsigned w) { return __uint_as_float(w & 0xffff0000u); }
__device__ __forceinline__ float h2f_lo(unsigned w) { return (float)__builtin_bit_cast(_Float16, (unsigned short)(w & 0xffffu)); }
__device__ __forceinline__ float h2f_hi(unsigned w) { return (float)__builtin_bit_cast(_Float16, (unsigned short)(w >> 16)); }
__device__ __forceinline__ float wave_sum(float v) {
#pragma unroll
    for (int o = 1; o < 64; o <<= 1) v += __shfl_xor(v, o);
    return v;
}
__device__ __forceinline__ float wave_max(float v) {
#pragma unroll
    for (int o = 1; o < 64; o <<= 1) v = fmaxf(v, __shfl_xor(v, o));
    return v;
}
__device__ __forceinline__ float silu_f(float v) { return v / (1.f + __expf(-v)); }
__device__ __forceinline__ float dot8(const uint4 a, const uint4 b) {
    return bflo(a.x) * bflo(b.x) + bfhi(a.x) * bfhi(b.x) + bflo(a.y) * bflo(b.y) + bfhi(a.y) * bfhi(b.y)
         + bflo(a.z) * bflo(b.z) + bfhi(a.z) * bfhi(b.z) + bflo(a.w) * bflo(b.w) + bfhi(a.w) * bfhi(b.w);
}
template <class P> __device__ __forceinline__ float dot8q(P q, const uint4 u) {
    return q[0] * bflo(u.x) + q[1] * bfhi(u.x) + q[2] * bflo(u.y) + q[3] * bfhi(u.y) + q[4] * bflo(u.z) + q[5] * bfhi(u.z) + q[6] * bflo(u.w) + q[7] * bfhi(u.w);
}

__device__ __forceinline__ int hw_lane() { unsigned z = 0u; asm volatile("" : "+s"(z)); return (int)__builtin_amdgcn_mbcnt_hi(~0u, __builtin_amdgcn_mbcnt_lo(~0u, z)); }
__device__ __forceinline__ int tid_opaque(int wv) { int t = (wv << 6) | hw_lane(); asm volatile("" : "+v"(t)); return t; }
template <class T> __device__ __forceinline__ LAS T* lptr(unsigned char* lds, int off) {
    unsigned b = (unsigned)(uintptr_t)((LAS unsigned char*)lds + off);
    asm volatile("" : "+s"(b));
    return (LAS T*)(uintptr_t)b;
}
__constant__ float c_inv_freq[16] = {1.0f, 0.5623413324356079f, 0.3162277638912201f, 0.17782793939113617f, 0.10000000149011612f, 0.05623413249850273f,
    0.03162277489900589f, 0.017782794311642647f, 0.009999999776482582f, 0.005623413249850273f, 0.003162277629598975f, 0.0017782794311642647f,
    0.0010000000474974513f, 0.000562341301701963f, 0.0003162277571391314f, 0.00017782794020604342f};

namespace pg8 {
#define PG8_LAS __attribute__((address_space(3)))
typedef unsigned short bf16_t;
typedef short bf16x8 __attribute__((ext_vector_type(8)));
typedef float f32x4 __attribute__((ext_vector_type(4)));
typedef unsigned u32x4 __attribute__((ext_vector_type(4)));
constexpr int BM = 256, BK = 64, HALF = 128, HTB = HALF * BK * 2  , STAGE_BYTES = 8 * HTB, NXCD = 8, WGM = 8;

__host__ __device__ __forceinline__ int lds_byte(int r, int c) { const int st = (r >> 4) * 2 + (c >> 5), rr = r & 15, cc = c & 31, ob = rr * 64 + cc * 2; return st * 1024 + (ob ^ (((ob >> 9) & 1) << 5)); }
__host__ __device__ __forceinline__ void stage_rc(int b, int& R, int& C) { const int st = b / 1024, sb = b % 1024, swz = sb ^ (((sb >> 9) & 1) << 5); R = (st >> 1) * 16 + swz / 64; C = (st & 1) * 32 + (swz % 64) / 2; }
__host__ __device__ __forceinline__ int perm32(int rho) { const int n = rho >> 4, i = rho & 15; return 8 * (i >> 2) + 4 * n + (i & 3); }

struct Unit { int pm, pn; };
struct Gemm { const bf16_t* A; const bf16_t* Bt; int M, N, K, lda, ldb; };

struct StaticOrder {
    int nM, nN, nwg, G, c;
    __host__ __device__ void init(int M, int N, int G_, int c_) { nM = M / BM; nN = N / BM; nwg = nM * nN; G = G_; c = c_; }
    __host__ __device__ bool next(int i, Unit& u) const {
        const long L = (long)i * G + c; if (L >= nwg) return false;
        int wgid = (int)L; { const int q = nwg / NXCD, r = nwg % NXCD, xcd = wgid % NXCD, off = wgid / NXCD; wgid = (xcd < r ? xcd * (q + 1) : r * (q + 1) + (xcd - r) * q) + off; }
        const int nig = WGM * nN, gid = wgid / nig, fm = gid * WGM, gsz = (nM - fm) < WGM ? (nM - fm) : WGM;
        u.pm = fm + ((wgid % nig) % gsz); u.pn = (wgid % nig) / gsz; return true;
    }
    __device__ __forceinline__ void a_ready(const Unit&) const {}
    __device__ __forceinline__ void done(const Unit&) const {}
};

__device__ __forceinline__ unsigned cvt_pk_bf16(float lo, float hi) { unsigned r; asm volatile("v_cvt_pk_bf16_f32 %0, %1, %2" : "=v"(r) : "v"(lo), "v"(hi)); return r; }
template <class Epi, class Sched, bool ALIGN_EPI = false, bool SP2 = false>
__device__ __forceinline__ void gemm_phase(PG8_LAS unsigned char* lds, const Gemm g, const Sched& S, const Epi& E, int wv_in) {
    unsigned z_ = 0u; asm volatile("" : "+s"(z_)); int tid = (wv_in << 6) | (int)__builtin_amdgcn_mbcnt_hi(~0u, __builtin_amdgcn_mbcnt_lo(~0u, z_)); asm volatile("" : "+v"(tid)); const int wid = __builtin_amdgcn_readfirstlane(tid >> 6), lane = tid & 63, wr = wid >> 2, wc = wid & 3, fr = lane & 15, fq = lane >> 4;
    const int K = g.K, nt = K / BK;
    unsigned voffA[2], voffB[2];
#pragma unroll
    for (int i = 0; i < 2; ++i) { int R, C; stage_rc(tid * 16 + i * 8192, R, C); const int Rb = Epi::PERM ? ((R & ~31) + perm32(R & 31)) : R;
        voffA[i] = (unsigned)(R * g.lda + C) * 2u; voffB[i] = (unsigned)(Rb * g.ldb + C) * 2u; }
    const size_t kstep = (size_t)(BK * 2);
    const size_t hstepA = (size_t)HALF * g.lda * 2, hstepB = (size_t)HALF * g.ldb * 2;
    const size_t tstepA = 2 * hstepA, tstepB = 2 * hstepB;
    const unsigned ldsw = (unsigned)wid * 1024u;
    const int aoff = lds_byte(wr * 64 + fr, fq * 8), boff = lds_byte(wc * 32 + fr, fq * 8);
#define PG8_SA(b, h) (((b) * 2 + (h)) * HTB)
#define PG8_SB(b, h) ((4 + (b) * 2 + (h)) * HTB)
#define PG8_STAGE(bufoff, gbase, voff) do { _Pragma("unroll") for (int _i = 0; _i < 2; ++_i) \
        __builtin_amdgcn_global_load_lds((const unsigned*)((const char*)(gbase) + (voff)[_i]), (PG8_LAS unsigned*)(lds + (bufoff) + ldsw + _i * 8192), 16, 0, 0); } while (0)
#define PG8_LDA(dst, b, h) do { _Pragma("unroll") for (int m = 0; m < 4; ++m) _Pragma("unroll") for (int k = 0; k < 2; ++k) dst[m][k] = *(const PG8_LAS bf16x8*)(lds + PG8_SA(b, h) + aoff + m * 2048 + k * 1024); } while (0)
#define PG8_LDB(dst, b, h) do { _Pragma("unroll") for (int n = 0; n < 2; ++n) _Pragma("unroll") for (int k = 0; k < 2; ++k) dst[n][k] = *(const PG8_LAS bf16x8*)(lds + PG8_SB(b, h) + boff + n * 2048 + k * 1024); } while (0)
#define PG8_MMA(ai, bj, At, Bt) do { __builtin_amdgcn_s_setprio(1); _Pragma("unroll") for (int m = 0; m < 4; ++m) _Pragma("unroll") for (int n = 0; n < 2; ++n) _Pragma("unroll") for (int k = 0; k < 2; ++k) \
        acc[ai][bj][m][n] = __builtin_amdgcn_mfma_f32_16x16x32_bf16(Bt[n][k], At[m][k], acc[ai][bj][m][n], 0, 0, 0); __builtin_amdgcn_s_setprio(0); } while (0)
#define PG8_WAIT_V(n) asm volatile("s_waitcnt vmcnt(" #n ")" ::: "memory")
#define PG8_WAIT_L(n) asm volatile("s_waitcnt lgkmcnt(" #n ")" ::: "memory")
#define PG8_BAR __builtin_amdgcn_s_barrier()
#define PG8_SCHED __builtin_amdgcn_sched_barrier(0)
    Unit cur, nxt; int ui = 0;
    if (!S.next(0, cur)) return;
    f32x4 acc[2][2][4][2];
#pragma unroll
    for (int a = 0; a < 2; ++a)
#pragma unroll
        for (int b = 0; b < 2; ++b)
#pragma unroll
            for (int m = 0; m < 4; ++m)
#pragma unroll
                for (int n = 0; n < 2; ++n) acc[a][b][m][n] = (f32x4){0.f, 0.f, 0.f, 0.f};
    bf16x8 At[4][2], B0[2][2], B1[2][2];
    const char* cA = (const char*)g.A + (size_t)cur.pm * tstepA; const char* cB = (const char*)g.Bt + (size_t)cur.pn * tstepB;
    S.a_ready(cur);
    if constexpr (SP2) {
        PG8_STAGE(PG8_SB(0, 0), cB, voffB); PG8_STAGE(PG8_SB(0, 1), cB + hstepB, voffB); PG8_STAGE(PG8_SA(0, 0), cA, voffA); PG8_STAGE(PG8_SA(0, 1), cA + hstepA, voffA);
        if (wr == 1) PG8_BAR;
        PG8_WAIT_V(2); PG8_BAR;
        PG8_STAGE(PG8_SB(1, 0), cB + kstep, voffB); PG8_STAGE(PG8_SA(1, 0), cA + kstep, voffA); PG8_STAGE(PG8_SB(1, 1), cB + hstepB + kstep, voffB);
        PG8_WAIT_V(6); PG8_BAR;
    } else {
        PG8_STAGE(PG8_SB(0, 0), cB, voffB); PG8_STAGE(PG8_SA(0, 0), cA, voffA); PG8_STAGE(PG8_SB(0, 1), cB + hstepB, voffB); PG8_STAGE(PG8_SA(0, 1), cA + hstepA, voffA);
        if (wr == 1) PG8_BAR;
        PG8_WAIT_V(4); PG8_BAR;
        PG8_STAGE(PG8_SB(1, 0), cB + kstep, voffB); PG8_STAGE(PG8_SA(1, 0), cA + kstep, voffA); PG8_STAGE(PG8_SB(1, 1), cB + hstepB + kstep, voffB);
        PG8_WAIT_V(6); PG8_BAR;
    }
    for (;;) {
        const bool has_next = S.next(ui + 1, nxt);
        const char* nA = has_next ? (const char*)g.A + (size_t)nxt.pm * tstepA : cA; const char* nB = has_next ? (const char*)g.Bt + (size_t)nxt.pn * tstepB : cB;
        for (int t = 0; t < nt; t += 2) {
            const bool last = (t == nt - 2);
            const char* a1 = cA + (size_t)(t + 1) * kstep;
            const char* a2 = last ? nA : cA + (size_t)(t + 2) * kstep; const char* b2 = last ? nB : cB + (size_t)(t + 2) * kstep;
            const char* a3 = a2 + kstep; const char* b3 = b2 + kstep;
            if (last && has_next) S.a_ready(nxt);
            if constexpr (SP2) {
            PG8_LDB(B0, 0, 0); PG8_LDB(B1, 0, 1); PG8_SCHED; PG8_LDA(At, 0, 0); PG8_STAGE(PG8_SA(1, 1), a1 + hstepA, voffA);
            PG8_WAIT_V(8); PG8_WAIT_L(0); PG8_BAR; PG8_MMA(0, 0, At, B0); PG8_MMA(0, 1, At, B1); PG8_BAR; PG8_SCHED;
            PG8_LDA(At, 0, 1); PG8_STAGE(PG8_SB(0, 0), b2, voffB); PG8_STAGE(PG8_SB(0, 1), b2 + hstepB, voffB); PG8_STAGE(PG8_SA(0, 0), a2, voffA);
            PG8_WAIT_V(8); PG8_WAIT_L(0); PG8_BAR; PG8_MMA(1, 0, At, B0); PG8_MMA(1, 1, At, B1); PG8_BAR; PG8_SCHED;
            PG8_LDB(B0, 1, 0); PG8_LDB(B1, 1, 1); PG8_SCHED; PG8_LDA(At, 1, 0); PG8_STAGE(PG8_SA(0, 1), a2 + hstepA, voffA);
            PG8_WAIT_V(8); PG8_WAIT_L(0); PG8_BAR; PG8_MMA(0, 0, At, B0); PG8_MMA(0, 1, At, B1); PG8_BAR; PG8_SCHED;
            PG8_LDA(At, 1, 1); PG8_STAGE(PG8_SB(1, 0), b3, voffB); PG8_STAGE(PG8_SB(1, 1), b3 + hstepB, voffB); PG8_STAGE(PG8_SA(1, 0), a3, voffA);
            PG8_WAIT_V(8); PG8_WAIT_L(0); PG8_BAR; PG8_MMA(1, 0, At, B0); PG8_MMA(1, 1, At, B1); PG8_BAR; PG8_SCHED;
            } else {
            PG8_LDB(B0, 0, 0); PG8_SCHED; PG8_LDA(At, 0, 0); PG8_STAGE(PG8_SA(1, 1), a1 + hstepA, voffA);
            PG8_WAIT_L(8); PG8_BAR; PG8_WAIT_L(0); PG8_MMA(0, 0, At, B0); PG8_BAR; PG8_SCHED;
            PG8_LDB(B1, 0, 1); PG8_STAGE(PG8_SB(0, 0), b2, voffB);
            PG8_BAR; PG8_WAIT_L(0); PG8_MMA(0, 1, At, B1); PG8_BAR;
            PG8_LDA(At, 0, 1); PG8_STAGE(PG8_SA(0, 0), a2, voffA);
            PG8_BAR; PG8_WAIT_L(0); PG8_MMA(1, 0, At, B0); PG8_BAR; PG8_SCHED;
            PG8_STAGE(PG8_SB(0, 1), b2 + hstepB, voffB);
            PG8_WAIT_V(6); PG8_BAR; PG8_MMA(1, 1, At, B1); PG8_BAR;
            PG8_LDB(B0, 1, 0); PG8_SCHED; PG8_LDA(At, 1, 0); PG8_STAGE(PG8_SA(0, 1), a2 + hstepA, voffA);
            PG8_WAIT_L(8); PG8_BAR; PG8_WAIT_L(0); PG8_MMA(0, 0, At, B0); PG8_BAR; PG8_SCHED;
            PG8_LDB(B1, 1, 1); PG8_STAGE(PG8_SB(1, 0), b3, voffB);
            PG8_BAR; PG8_WAIT_L(0); PG8_MMA(0, 1, At, B1); PG8_BAR;
            PG8_LDA(At, 1, 1); PG8_STAGE(PG8_SA(1, 0), a3, voffA);
            PG8_BAR; PG8_WAIT_L(0); PG8_MMA(1, 0, At, B0); PG8_BAR; PG8_SCHED;
            PG8_STAGE(PG8_SB(1, 1), b3 + hstepB, voffB);
            PG8_WAIT_V(6); PG8_BAR; PG8_MMA(1, 1, At, B1); PG8_BAR;
            }
        }
        if constexpr (ALIGN_EPI) { if (wr == 0) PG8_BAR; }
        if constexpr (!Epi::AFTER_DRAIN) { E(acc, cur, wr, wc, fr, fq); S.done(cur); }
        if (!has_next) break;
#pragma unroll
        for (int a = 0; a < 2; ++a)
#pragma unroll
            for (int b = 0; b < 2; ++b)
#pragma unroll
                for (int m = 0; m < 4; ++m)
#pragma unroll
                    for (int n = 0; n < 2; ++n) acc[a][b][m][n] = (f32x4){0.f, 0.f, 0.f, 0.f};
        cur = nxt; cA = nA; cB = nB; ++ui;
        if constexpr (ALIGN_EPI) { if (wr == 1) PG8_BAR; }
    }
    PG8_WAIT_V(0);
    if constexpr (!ALIGN_EPI) { if (wr == 0) PG8_BAR; }
    PG8_BAR;
    if constexpr (Epi::AFTER_DRAIN) { E.fused(acc, cur, wr, wc, fr, fq, lds, wid, lane); S.done(cur); }
#undef PG8_SA
#undef PG8_SB
#undef PG8_STAGE
#undef PG8_LDA
#undef PG8_LDB
#undef PG8_MMA
#undef PG8_WAIT_V
#undef PG8_WAIT_L
#undef PG8_BAR
#undef PG8_SCHED
}
}


#define XB_TMO      128
#define XB_XCNT(j)  (256  + 64 * (j))
#define XB_XSUB(j)  (1280 + 64 * (j))
#define XB_XGEN(j)  (2304 + 64 * (j))
#define XB_TOP      3328
#define XB_TOPGEN   3392
#define XCD_BAR_WORDS 3456
#define XB_SPIN_CAP (1u << 18)

__device__ __forceinline__ unsigned xb_ld(unsigned* p)              { return __hip_atomic_load(p, __ATOMIC_RELAXED, __HIP_MEMORY_SCOPE_AGENT); }
__device__ __forceinline__ unsigned xb_add(unsigned* p, unsigned v) { return __hip_atomic_fetch_add(p, v, __ATOMIC_RELAXED, __HIP_MEMORY_SCOPE_AGENT); }
__device__ __forceinline__ unsigned xb_xcc_id() { return (unsigned)__builtin_amdgcn_s_getreg((3 << 11) | 20) & 0xFu; }
#define XB_SPIN(cond, bar) do { unsigned _sp = 0; while (cond) { __builtin_amdgcn_s_sleep(1); \
    if ((++_sp & 255u) == 0u) { if (xb_ld(&(bar)[XB_TMO])) break; if (_sp > XB_SPIN_CAP) { atomicAdd(&(bar)[XB_TMO], 1u); break; } } } } while (0)

struct XcdBarrier {
    unsigned* bar; unsigned x; int wv;
    volatile LAS unsigned* st;
};

__device__ __forceinline__ XcdBarrier xcd_barrier_post(unsigned* bar, volatile LAS unsigned* st, int wv) {
    XcdBarrier b; b.bar = bar; b.x = xb_xcc_id(); b.st = st;
    b.wv = wv; if (wv == 0 && hw_lane() == 0) (void)xb_add(&bar[XB_XCNT(b.x)], 1u);
    return b;
}
__device__ __forceinline__ void xcd_barrier_complete(unsigned* bar, unsigned x, unsigned& nloc, unsigned& nx) {
    const unsigned G = gridDim.x * gridDim.y * gridDim.z;
    unsigned sum, cnt, mine, sp = 0u;
    for (;;) {
        sum = 0u; cnt = 0u; mine = 0u;
#pragma unroll
        for (unsigned j = 0; j < 16; ++j) { const unsigned c = xb_ld(&bar[XB_XCNT(j)]); sum += c; cnt += (c > 0u) ? 1u : 0u; mine = (j == x) ? c : mine; }
        if (sum == G) break;
        __builtin_amdgcn_s_sleep(1);
        if ((++sp & 255u) == 0u) { if (xb_ld(&bar[XB_TMO])) break; if (sp > XB_SPIN_CAP) { atomicAdd(&bar[XB_TMO], 1u); break; } }
    }
    nloc = mine > 0u ? mine : 1u; nx = cnt > 0u ? cnt : 1u;
}

__device__ __forceinline__ void xcd_barrier(const XcdBarrier& b) {
    asm volatile("s_waitcnt vmcnt(0)" ::: "memory");
    __syncthreads();
    if (b.wv == 0 && hw_lane() == 0) {
        unsigned* bar = b.bar;
        __builtin_amdgcn_s_waitcnt(0);
        unsigned nloc = b.st[0], nx = b.st[1];
        if (nloc == 0u) { xcd_barrier_complete(bar, b.x, nloc, nx); b.st[0] = nloc; b.st[1] = nx; }
        const unsigned old = xb_add(&bar[XB_XSUB(b.x)], 1u);
        const unsigned gen = old / nloc;
        if (old + 1u == (gen + 1u) * nloc) {
            __builtin_amdgcn_fence(__ATOMIC_RELEASE, "agent");
            asm volatile("s_waitcnt vmcnt(0)" ::: "memory");
            const unsigned og = xb_add(&bar[XB_TOP], 1u);
            const unsigned tg = og / nx;
            if (og + 1u == (tg + 1u) * nx) xb_add(&bar[XB_TOPGEN], 1u);
            else XB_SPIN(xb_ld(&bar[XB_TOPGEN]) == tg, bar);
            __builtin_amdgcn_fence(__ATOMIC_ACQUIRE, "agent");
            xb_add(&bar[XB_XGEN(b.x)], 1u);
            asm volatile("s_waitcnt vmcnt(0)" ::: "memory");
        } else {
            XB_SPIN(xb_ld(&bar[XB_XGEN(b.x)]) == gen, bar);
            __builtin_amdgcn_fence(__ATOMIC_ACQUIRE, "agent");
            asm volatile("s_waitcnt vmcnt(0)" ::: "memory");
        }
    }
    __syncthreads();
}


struct Args {
    const float *x, *c, *ada_w, *ada_b, *ln_mix_g, *ln_mix_b, *ln_ffn_g, *ln_ffn_b, *ev_w_in, *ev_conv_w, *ev_w_out, *od_w_in, *pool_w, *pool_scale,
                *q_norm_g, *w_uq, *kv_norm_g, *w_ukv, *od_w_out, *ffn_w_up, *ffn_conv_w, *ffn_w_down;
    float* out; unsigned char* ws; int ph_lo, ph_hi;
};

#define AS4 __attribute__((address_space(4)))
typedef const AS4 Args KArgs;
__device__ __forceinline__ KArgs& kargs() { unsigned z = 0; asm volatile("" : "+s"(z)); return *(KArgs*)((const AS4 char*)__builtin_amdgcn_kernarg_segment_ptr() + z); }

__device__ __forceinline__ void st_bf16x4(bf16_t* p, float a, float b, float c, float d) { uint2 w; w.x = pk2(a, b); w.y = pk2(c, d); *(uint2*)p = w; }
struct EpiIn0 {
    const float* bias; bf16_t *q, *k, *v, *bg, *cg, *xc; f16_t *qi, *ki; float* wi;
    __device__ __forceinline__ void store4(int r, int c, float a, float b, float cc, float d) const {
        if (c >= EVEN_IN) return;
        const float4 bv = *(const float4*)(bias + c); a += bv.x; b += bv.y; cc += bv.z; d += bv.w;
        if (c < 512) { st_bf16x4(q + (size_t)r * 512 + c, a * 0.125f, b * 0.125f, cc * 0.125f, d * 0.125f); return; }
        if (c < 1024) { st_bf16x4(k + (size_t)r * 512 + (c - 512), a, b, cc, d); return; }
        if (c < 1536) { st_bf16x4(v + (size_t)r * 512 + (c - 1024), a, b, cc, d); return; }
        if (c < 2048) { f16_t* p = qi + (size_t)r * 512 + (c - 1536); p[0] = (f16_t)a; p[1] = (f16_t)b; p[2] = (f16_t)cc; p[3] = (f16_t)d; return; }
        if (c < 2112) { f16_t* p = ki + (size_t)r * 64 + (c - 2048); p[0] = (f16_t)a; p[1] = (f16_t)b; p[2] = (f16_t)cc; p[3] = (f16_t)d; return; }
        if (c < 2120) { *(float4*)(wi + (size_t)r * 8 + (c - 2112)) = make_float4(a, b, cc, d); return; }
        if (c < 2632) { st_bf16x4(bg + (size_t)r * 512 + (c - 2120), a, b, cc, d); return; }
        if (c < 3144) { st_bf16x4(cg + (size_t)r * 512 + (c - 2632), a, b, cc, d); return; }
        st_bf16x4(xc + (size_t)r * 512 + (c - 3144), a, b, cc, d);
    }
};
struct EpiResid {
    const float* res; float* pre;
    __device__ __forceinline__ void store4(int r, int c, float a, float b, float cc, float d) const {
        const float4 x = *(const float4*)(res + (size_t)r * D + c);
        *(float4*)(pre + (size_t)r * D + c) = make_float4(DN_ALPHA * x.x + a, DN_ALPHA * x.y + b, DN_ALPHA * x.z + cc, DN_ALPHA * x.w + d);
    }
};
struct EpiBiasBf16 {
    const float* bias; bf16_t* out; int ldc;
    __device__ __forceinline__ void store4(int r, int c, float a, float b, float cc, float d) const {
        const float4 bv = *(const float4*)(bias + c);
        st_bf16x4(out + (size_t)r * ldc + c, a + bv.x, b + bv.y, cc + bv.z, d + bv.w);
    }
};
struct EpiPlainBf16 {
    bf16_t* out; int ldc;
    __device__ __forceinline__ void store4(int r, int c, float a, float b, float cc, float d) const { st_bf16x4(out + (size_t)r * ldc + c, a, b, cc, d); }
};
struct EpiRowScaleBf16 {
    const float* rs; int which; bf16_t* out; int ldc;
    __device__ __forceinline__ void store4(int r, int c, float a, float b, float cc, float d) const {
        const float s = rs[(size_t)r * 2 + which]; st_bf16x4(out + (size_t)r * ldc + c, a * s, b * s, cc * s, d * s);
    }
};
struct EpiColScaleBf16 {
    const float* rs; int which; bf16_t* out; int ldc;
    __device__ __forceinline__ void store4(int r, int c, float a, float b, float cc, float d) const {
        st_bf16x4(out + (size_t)r * ldc + c, a * rs[(size_t)c * 2 + which], b * rs[(size_t)(c + 1) * 2 + which], cc * rs[(size_t)(c + 2) * 2 + which], d * rs[(size_t)(c + 3) * 2 + which]);
    }
};
struct EpiQ1 {
    const float* rs; const float* rope; bf16_t* out;
    __device__ __forceinline__ void store4(int r, int c, float a, float b, float cc, float d) const {
        const float s = rs[(size_t)r * 2]; a *= s; b *= s; cc *= s; d *= s;
        const int e = c % 96;
        if (e >= 64) {
            const int i = (e - 64) >> 1;
            const float c0 = rope[(size_t)r * 16 + i], s0 = rope[(size_t)S * 16 + (size_t)r * 16 + i];
            const float c1 = rope[(size_t)r * 16 + i + 1], s1 = rope[(size_t)S * 16 + (size_t)r * 16 + i + 1];
            const float a2 = a * c0 - b * s0, b2 = b * c0 + a * s0, c2 = cc * c1 - d * s1, d2 = d * c1 + cc * s1;
            a = a2; b = b2; cc = c2; d = d2;
        }
        st_bf16x4(out + (size_t)r * 768 + c, a, b, cc, d);
    }
};
template <class F> struct EpiFn {
    static constexpr bool PERM = true, AFTER_DRAIN = false;
    F f;
    __device__ __forceinline__ void operator()(const pg8::f32x4 (&acc)[2][2][4][2], const pg8::Unit& u, int wr, int wc, int fr, int fq) const {
        { int l = hw_lane(); asm volatile("" : "+v"(l)); fr = l & 15; fq = l >> 4; }
        const int row0 = u.pm * 256 + wr * 64 + fr, col0 = u.pn * 256 + wc * 32 + 8 * fq;
#pragma unroll
        for (int ai = 0; ai < 2; ++ai)
#pragma unroll
            for (int m = 0; m < 4; ++m)
#pragma unroll
                for (int bj = 0; bj < 2; ++bj)
#pragma unroll
                    for (int n = 0; n < 2; ++n) { const pg8::f32x4 v = acc[ai][bj][m][n]; f.store4(row0 + ai * 128 + m * 16, col0 + bj * 128 + 4 * n, v[0], v[1], v[2], v[3]);
                                                  asm volatile("" ::: "memory"); }
    }
};
template <class E>
__device__ __forceinline__ void run_gemm_epi(unsigned char* lds, const bf16_t* A, int lda, const bf16_t* Bt, int ldb, int M, int N, int K, const E& e, int nb, int bid, int wv) {
    asm volatile("" : "+s"(K), "+s"(lda), "+s"(ldb));
    pg8::Gemm g{A, Bt, M, N, K, lda, ldb}; pg8::StaticOrder So; So.init(M, N, nb, bid);
    pg8::gemm_phase<E, pg8::StaticOrder, true, true>((PG8_LAS unsigned char*)lds, g, So, e, wv);
}
template <class F>
__device__ __forceinline__ void run_gemm(unsigned char* lds, const bf16_t* A, int lda, const bf16_t* Bt, int ldb, int M, int N, int K, const F& f, int nb, int bid, int wv) {
    asm volatile("" : "+s"(K), "+s"(lda), "+s"(ldb));
    pg8::Gemm g{A, Bt, M, N, K, lda, ldb}; pg8::StaticOrder So; So.init(M, N, nb, bid);
    EpiFn<F> E{f};
    pg8::gemm_phase<EpiFn<F>, pg8::StaticOrder, true, true>((PG8_LAS unsigned char*)lds, g, So, E, wv);
}

template <int N> __device__ __forceinline__ float prev_row(float prevgroup, float cur) {
    const int t = __builtin_amdgcn_update_dpp(0, __builtin_bit_cast(int, prevgroup), 0x120 + N, 0xf, 0xf, true);
    return __builtin_bit_cast(float, __builtin_amdgcn_update_dpp(t, __builtin_bit_cast(int, cur), 0x110 + N, 0xf, 0xf, false));
}
struct EpiFfnUp {
    static constexpr bool PERM = true, AFTER_DRAIN = false;
    const float* bias; const float* cw; bf16_t* g; bf16_t* hu;
    template <int HALFSEL>
    __device__ __forceinline__ void half(const pg8::f32x4 (&acc)[2][2][4][2], int ai, int n, int fr, const float* bp, const float* cp, bf16_t* h01, bf16_t* h23, float (&o)[4][4]) const {
#pragma unroll
        for (int e = 0; e < 4; ++e) {
            const float be = bp[e], c0e = cp[e], c1e = cp[DFF2 + e], c2e = cp[2 * DFF2 + e];
            float uu[4];
#pragma unroll
            for (int m = 0; m < 4; ++m) uu[m] = acc[ai][HALFSEL][m][n][e] + be;
#pragma unroll
            for (int m = 0; m < 4; ++m) {
                const float p1 = prev_row<1>(uu[m > 0 ? m - 1 : 0], uu[m]), p2 = prev_row<2>(uu[m > 0 ? m - 1 : 0], uu[m]);
                const float cvv = c0e * p2 + c1e * p1 + c2e * uu[m];
                if (HALFSEL == 0) o[m][e] = cvv; else o[m][e] *= silu_f(cvv);
            }
            if (fr < 2) h01[HALFSEL * 128 + e] = f2bf(uu[0]);
            if (fr >= 14) h23[HALFSEL * 128 + e] = f2bf(uu[3]);
            asm volatile("" ::: "memory"); __builtin_amdgcn_sched_barrier(0);
        }
    }
    __device__ __forceinline__ void operator()(const pg8::f32x4 (&acc)[2][2][4][2], const pg8::Unit& u, int wr, int wc, int fr, int fq) const {
        { int l = hw_lane(); asm volatile("" : "+v"(l)); fr = l & 15; fq = l >> 4; }
        const int jl = wc * 32 + 8 * fq, j0 = u.pn * 128 + jl, nb0 = u.pn * 256 + jl;
#pragma unroll
        for (int n = 0; n < 2; ++n) {
#pragma unroll
            for (int ai = 0; ai < 2; ++ai) {
                const int row0 = u.pm * 256 + ai * 128 + wr * 64, blk = row0 >> 6;
                bf16_t* h01 = hu + ((size_t)blk * 4 + (fr & 1)) * DFF2 + nb0 + 4 * n;
                bf16_t* h23 = hu + ((size_t)blk * 4 + 2 + (fr & 1)) * DFF2 + nb0 + 4 * n;
                float o[4][4];
                half<0>(acc, ai, n, fr, bias + nb0 + 4 * n, cw + j0 + 4 * n, h01, h23, o);
                half<1>(acc, ai, n, fr, bias + nb0 + 128 + 4 * n, cw + DFF + j0 + 4 * n, h01, h23, o);
#pragma unroll
                for (int m = 0; m < 4; ++m) {
                    if (m > 0 || fr >= 2) st_bf16x4(g + (size_t)(row0 + 16 * m + fr) * DFF + j0 + 4 * n, o[m][0], o[m][1], o[m][2], o[m][3]);
                }
                asm volatile("" ::: "memory");
            }
        }
    }
};

__device__ __forceinline__ void ph_mod(KArgs& a, unsigned char* lds, int bid, int nb, int wv) {
    float* mod = (float*)(a.ws + WS_MOD);
    LAS float* red = lptr<float>(lds, 0);
    const int tid = tid_opaque(wv), lane = tid & 63, wave = tid >> 6;
    for (int it = bid; it < 192; it += nb) {
        const int n = it * 64 + lane, l = n / 6144, nn = n % 6144;
        const float* w = a.ada_w + (size_t)l * 1024 * 6144 + nn;
        float acc = 0.f;
        for (int k = wave * 128; k < wave * 128 + 128; ++k) acc += silu_f(a.c[k]) * w[(size_t)k * 6144];
        red[wave * 64 + lane] = acc;
        __syncthreads();
        if (wave == 0) { float s = 0.f;
#pragma unroll
            for (int q = 0; q < 8; ++q) s += red[q * 64 + lane];
            mod[n] = s + a.ada_b[n]; }
        __syncthreads();
    }
    float* rope = (float*)(a.ws + WS_ROPE);
    for (int gid = bid * NT + tid; gid < S * 16; gid += nb * NT) {
        const int t = gid >> 4, i = gid & 15;
        const float ang = (float)t * c_inv_freq[i];
        double rev = (double)ang * 0.15915494309189535;
        rev -= rint(rev);
        const float f = (float)rev;
        rope[gid] = __builtin_amdgcn_cosf(f);
        rope[S * 16 + gid] = __builtin_amdgcn_sinf(f);
    }
}
__device__ __forceinline__ int src_col(int mode, int n, int Nsrc) {
    if (mode == 0) return n < Nsrc ? n : -1;
    if (mode == 1) { const int tile = n >> 8, i = n & 255; return i < 128 ? tile * 128 + i : DFF + tile * 128 + (i - 128); }
    if (mode == 2) { const int h = n / 96, e = n % 96; if (e < 64) return h * 96 + e; const int i = (e - 64) >> 1; return h * 96 + 64 + ((e & 1) ? 16 + i : i); }
    if (mode == 3) { const int h = n >> 6, d = n & 63; return h * 128 + d; }
    { const int h = n >> 6, d = n & 63; return h * 128 + 64 + d; }
}
__device__ __forceinline__ void prep_item(const float* W, int K, int Nsrc, int Npad, int mode, const float* rs1p, const float* rs, const float* cs1p, float cst, bf16_t* dst,
                                          LAS float* scr, int item, int lane) {
    const int nblk = Npad / 32, kb = item / nblk, nbk = item % nblk, k0 = kb * 64, n0 = nbk * 32, nl = lane & 31;
    const int sn = src_col(mode, n0 + nl, Nsrc);
    float cs = cst; if (sn >= 0 && cs1p) cs *= 1.f + cs1p[sn];
#pragma unroll 8
    for (int i = 0; i < 32; ++i) {
        const int kk = 2 * i + (lane >> 5), k = k0 + kk;
        float v = 0.f;
        if (sn >= 0) { v = W[(size_t)k * Nsrc + sn] * cs; if (rs1p) v *= 1.f + rs1p[k]; if (rs) v *= rs[k]; }
        scr[kk * 33 + nl] = v;
    }
    LDS_WAIT();
    const int c = lane & 7;
#pragma unroll
    for (int j = 0; j < 4; ++j) {
        const int n = (lane >> 3) + 8 * j; const LAS float* s = scr + (8 * c) * 33 + n;
        uint4 o; o.x = pk2(s[0 * 33], s[1 * 33]); o.y = pk2(s[2 * 33], s[3 * 33]); o.z = pk2(s[4 * 33], s[5 * 33]); o.w = pk2(s[6 * 33], s[7 * 33]);
        *(uint4*)(dst + (size_t)(n0 + n) * K + k0 + 8 * c) = o;
    }
    LDS_WAIT();
}
__device__ __forceinline__ void bias_item(const float* W, int K, int Nsrc, int mode, const float* shift, float* bias, LAS float* red, int item, int wv) {
    const int tid = tid_opaque(wv), lane = tid & 63, wave = tid >> 6;
    const int n = item * 64 + lane, sn = src_col(mode, n, Nsrc), ks = K / 8;
    float acc = 0.f;
    if (sn >= 0) for (int k = wave * ks; k < wave * ks + ks; ++k) acc += shift[k] * W[(size_t)k * Nsrc + sn];
    red[wave * 64 + lane] = acc;
    __syncthreads();
    if (wave == 0) { float s = 0.f;
#pragma unroll
        for (int q = 0; q < 8; ++q) s += red[q * 64 + lane];
        bias[n] = s; }
    __syncthreads();
}
__device__ __forceinline__ void ph_prep(KArgs& a, unsigned char* lds, int bid, int nb, int wv) {
    const int tid = tid_opaque(wv), lane = tid & 63, wave = tid >> 6;
    unsigned char* ws = a.ws;
    const float* m0 = (const float*)(ws + WS_MOD); const float* m1 = m0 + 6144;
    {
        LAS float* red = lptr<float>(lds, 0);
        for (int it = bid; it < 256; it += nb) {
            int r = it;
            if (r < 60) { bias_item(a.ev_w_in, 1024, EVEN_IN, 0, m0, (float*)(ws + WS_BIAS_IN0), red, r, wv); continue; } r -= 60;
            if (r < 88) { bias_item(a.ffn_w_up, 1024, DFF2, 1, m0 + 3072, (float*)(ws + WS_BIAS_UP0), red, r, wv); continue; } r -= 88;
            if (r < 20) { bias_item(a.od_w_in, 1024, ODD_IN, 0, m1, (float*)(ws + WS_BIAS_IN1), red, r, wv); continue; } r -= 20;
            bias_item(a.ffn_w_up + (size_t)1024 * DFF2, 1024, DFF2, 1, m1 + 3072, (float*)(ws + WS_BIAS_UP1), red, r, wv);
        }
    }
    {
        LAS float* scr = lptr<float>(lds, 4096) + wave * 2176;
        const int gw = bid * 8 + wave, NGW = nb * 8;
        constexpr int I_IN0 = 16 * (EVEN_IN_P / 32), I_SQ = 16 * 32, I_UP = 16 * (DFF2 / 32), I_DN = 44 * 32, I_IN1 = 16 * (ODD_IN_P / 32), I_UQ = 6 * 24, I_UKV = 4 * 16;
        constexpr int NITEMS = I_IN0 + I_SQ + I_UP + I_DN + I_IN1 + I_UQ + 2 * I_UKV + I_SQ + I_UP + I_DN;
        for (int it = gw; it < NITEMS; it += NGW) {
            int r = it;
            if (r < I_IN0) { prep_item(a.ev_w_in, 1024, EVEN_IN, EVEN_IN_P, 0, m0 + 1024, nullptr, nullptr, 1.f, (bf16_t*)(ws + WS_W_IN0), scr, r, lane); continue; } r -= I_IN0;
            if (r < I_SQ) { prep_item(a.ev_w_out, 1024, 1024, 1024, 0, nullptr, nullptr, m0 + 2048, 1.f, (bf16_t*)(ws + WS_W_OUT0), scr, r, lane); continue; } r -= I_SQ;
            if (r < I_UP) { prep_item(a.ffn_w_up, 1024, DFF2, DFF2, 1, m0 + 4096, nullptr, nullptr, 1.f, (bf16_t*)(ws + WS_W_UP0), scr, r, lane); continue; } r -= I_UP;
            if (r < I_DN) { prep_item(a.ffn_w_down, DFF, 1024, 1024, 0, nullptr, nullptr, m0 + 5120, 1.f, (bf16_t*)(ws + WS_W_DN0), scr, r, lane); continue; } r -= I_DN;
            if (r < I_IN1) { prep_item(a.od_w_in, 1024, ODD_IN, ODD_IN_P, 0, m1 + 1024, nullptr, nullptr, 1.f, (bf16_t*)(ws + WS_W_IN1), scr, r, lane); continue; } r -= I_IN1;
            if (r < I_UQ) { prep_item(a.w_uq, 384, 768, 768, 2, nullptr, a.q_norm_g, nullptr, MLA_QSCALE, (bf16_t*)(ws + WS_W_UQ), scr, r, lane); continue; } r -= I_UQ;
            if (r < I_UKV) { prep_item(a.w_ukv, 256, 1024, 512, 3, nullptr, a.kv_norm_g, nullptr, 1.f, (bf16_t*)(ws + WS_W_UK), scr, r, lane); continue; } r -= I_UKV;
            if (r < I_UKV) { prep_item(a.w_ukv, 256, 1024, 512, 4, nullptr, a.kv_norm_g, nullptr, 1.f, (bf16_t*)(ws + WS_W_UV), scr, r, lane); continue; } r -= I_UKV;
            if (r < I_SQ) { prep_item(a.od_w_out, 1024, 1024, 1024, 0, nullptr, nullptr, m1 + 2048, 1.f, (bf16_t*)(ws + WS_W_OUT1), scr, r, lane); continue; } r -= I_SQ;
            if (r < I_UP) { prep_item(a.ffn_w_up + (size_t)1024 * DFF2, 1024, DFF2, DFF2, 1, m1 + 4096, nullptr, nullptr, 1.f, (bf16_t*)(ws + WS_W_UP1), scr, r, lane); continue; } r -= I_UP;
            prep_item(a.ffn_w_down + (size_t)DFF * 1024, DFF, 1024, 1024, 0, nullptr, nullptr, m1 + 5120, 1.f, (bf16_t*)(ws + WS_W_DN1), scr, r, lane);
        }
    }
    {
        bf16_t* dst = (bf16_t*)(ws + WS_W_POOL);
        for (int gid = bid * NT + tid; gid < 512 * 512; gid += nb * NT) {
            const int n = gid >> 9, k = gid & 511, g = n >> 7, d = n & 127;
            float v = 0.f;
            if ((k >> 7) == g) v = a.pool_w[((size_t)g * 128 + (k & 127)) * 128 + d] * a.pool_scale[n];
            dst[gid] = f2bf(v);
        }
    }
    {
        bf16_t* xb = (bf16_t*)(ws + WS_XB);
        for (int gid = bid * NT + tid; gid < S * D / 4; gid += nb * NT) {
            const float4 v = ((const float4*)a.x)[gid];
            st_bf16x4(xb + (size_t)gid * 4, v.x, v.y, v.z, v.w);
        }
    }
}
__device__ __forceinline__ void ph_ln(float* pre, const float* g, const float* b, bf16_t* xb, int bid, int nb, int wv) {
    const int lane = tid_opaque(wv) & 63, wave = tid_opaque(wv) >> 6;
    for (int row = bid * 8 + wave; row < S; row += nb * 8) {
        float4* xr = (float4*)(pre + (size_t)row * D) + lane;
        float4 v[4]; float s = 0.f;
#pragma unroll
        for (int j = 0; j < 4; ++j) { v[j] = xr[64 * j]; s += (v[j].x + v[j].y) + (v[j].z + v[j].w); }
        const float mean = wave_sum(s) * (1.f / D); float s2 = 0.f;
#pragma unroll
        for (int j = 0; j < 4; ++j) { v[j].x -= mean; v[j].y -= mean; v[j].z -= mean; v[j].w -= mean; s2 += (v[j].x * v[j].x + v[j].y * v[j].y) + (v[j].z * v[j].z + v[j].w * v[j].w); }
        const float rstd = 1.f / sqrtf(wave_sum(s2) * (1.f / D) + LN_EPS);
#pragma unroll
        for (int j = 0; j < 4; ++j) {
            const float4 gg = ((const float4*)g)[64 * j + lane], bb = ((const float4*)b)[64 * j + lane];
            float4 o; o.x = v[j].x * rstd * gg.x + bb.x; o.y = v[j].y * rstd * gg.y + bb.y; o.z = v[j].z * rstd * gg.z + bb.z; o.w = v[j].w * rstd * gg.w + bb.w;
            xr[64 * j] = o;
            st_bf16x4(xb + (size_t)row * D + (64 * j + lane) * 4, o.x, o.y, o.z, o.w);
        }
    }
}
__device__ __forceinline__ void ph_shortconv(KArgs& a, int bid, int nb, int wv) {
    const bf16_t* bg = (const bf16_t*)(a.ws + WS_BG); const bf16_t* cg = (const bf16_t*)(a.ws + WS_CG); const bf16_t* xc = (const bf16_t*)(a.ws + WS_XC);
    bf16_t* y = (bf16_t*)(a.ws + WS_Y0);
    for (int gid = bid * NT + tid_opaque(wv); gid < S * 64; gid += nb * NT) {
        const int t = gid >> 6, c0 = (gid & 63) * 8;
        float acc[8];
#pragma unroll
        for (int e = 0; e < 8; ++e) acc[e] = 0.f;
#pragma unroll
        for (int kk = 0; kk < 3; ++kk) {
            const int tt = t - 2 + kk;
            if (tt >= 0) {
                const uint4 cgv = *(const uint4*)(cg + (size_t)tt * 512 + c0), xv = *(const uint4*)(xc + (size_t)tt * 512 + c0);
                const float4 w0 = *(const float4*)(a.ev_conv_w + kk * 512 + c0), w1 = *(const float4*)(a.ev_conv_w + kk * 512 + c0 + 4);
                acc[0] += w0.x * bflo(cgv.x) * bflo(xv.x); acc[1] += w0.y * bfhi(cgv.x) * bfhi(xv.x);
                acc[2] += w0.z * bflo(cgv.y) * bflo(xv.y); acc[3] += w0.w * bfhi(cgv.y) * bfhi(xv.y);
                acc[4] += w1.x * bflo(cgv.z) * bflo(xv.z); acc[5] += w1.y * bfhi(cgv.z) * bfhi(xv.z);
                acc[6] += w1.z * bflo(cgv.w) * bflo(xv.w); acc[7] += w1.w * bfhi(cgv.w) * bfhi(xv.w);
            }
        }
        const uint4 b = *(const uint4*)(bg + (size_t)t * 512 + c0);
        uint4 o; o.x = pk2(bflo(b.x) * acc[0], bfhi(b.x) * acc[1]); o.y = pk2(bflo(b.y) * acc[2], bfhi(b.y) * acc[3]);
        o.z = pk2(bflo(b.z) * acc[4], bfhi(b.z) * acc[5]); o.w = pk2(bflo(b.w) * acc[6], bfhi(b.w) * acc[7]);
        *(uint4*)(y + (size_t)t * 1024 + 512 + c0) = o;
    }
}
__device__ __forceinline__ void nv_topk(KArgs& a, unsigned char* lds, int t, int wv) {
    const f16_t* qi = (const f16_t*)(a.ws + WS_QI); const f16_t* ki = (const f16_t*)(a.ws + WS_KI); const float* wi = (const float*)(a.ws + WS_WI);
    unsigned short* out = (unsigned short*)(a.ws + WS_IDX) + (size_t)t * TOPK;
    LAS unsigned* key = lptr<unsigned>(lds, 0);
    LAS float* qs = lptr<float>(lds, 65536);
    LAS unsigned* sc = lptr<unsigned>(lds, 65536 + 2048);
    const int tid = tid_opaque(wv), lane = tid & 63, wq = tid >> 6, N = (t / 64 + 1) * 64;
    if (N <= TOPK) { if (tid < N) out[tid] = (unsigned short)tid; return; }
    qs[tid] = (float)qi[(size_t)t * 512 + tid];
    float w[8];
#pragma unroll
    for (int h = 0; h < 8; ++h) w[h] = wi[(size_t)t * 8 + h];
    __syncthreads();
    for (int s = tid; s < N; s += NT) {
        asm volatile("" ::: "memory");
        const uint4* kp = (const uint4*)(ki + (size_t)s * 64);
        uint4 kq[8];
#pragma unroll
        for (int j = 0; j < 8; ++j) kq[j] = kp[j];
        float score = 0.f;
#pragma unroll
        for (int h = 0; h < 8; ++h) {
            float d = 0.f;
#pragma unroll
            for (int j = 0; j < 8; ++j) { const LAS float* q = qs + h * 64 + j * 8; const uint4 u = kq[j];
                d += q[0] * h2f_lo(u.x) + q[1] * h2f_hi(u.x) + q[2] * h2f_lo(u.y) + q[3] * h2f_hi(u.y) + q[4] * h2f_lo(u.z) + q[5] * h2f_hi(u.z) + q[6] * h2f_lo(u.w) + q[7] * h2f_hi(u.w); }
            score += w[h] * fmaxf(d, 0.f);
        }
        unsigned u = __float_as_uint(score); u = (u & 0x80000000u) ? ~u : (u | 0x80000000u);
        key[s] = u;
    }
    __syncthreads();
    unsigned T = 0;
    for (int bit = 31; bit >= 0; --bit) {
        const unsigned cand = T | (1u << bit);
        if (tid == 0) sc[0] = 0;
        __syncthreads();
        unsigned c = 0;
        for (int s = tid; s < N; s += NT) c += (key[s] >= cand) ? 1u : 0u;
        __hip_atomic_fetch_add(&sc[0], c, __ATOMIC_RELAXED, __HIP_MEMORY_SCOPE_WORKGROUP);
        __syncthreads();
        if (sc[0] >= (unsigned)TOPK) T = cand;
        __syncthreads();
    }
    if (tid == 0) sc[0] = 0;
    __syncthreads();
    for (int s = tid; s < N; s += NT) if (key[s] > T) { const unsigned p = __hip_atomic_fetch_add(&sc[0], 1u, __ATOMIC_RELAXED, __HIP_MEMORY_SCOPE_WORKGROUP); out[p] = (unsigned short)s; }
    __syncthreads();
    const unsigned ngt = sc[0], need = TOPK - ngt;
    __syncthreads();
    unsigned base = 0;
    for (int s0 = 0; s0 < N; s0 += NT) {
        const int s = s0 + tid;
        const bool eq = (s < N) && (key[s] == T);
        const unsigned long long m = __ballot(eq);
        if (lane == 0) sc[1 + wq] = (unsigned)__popcll(m);
        __syncthreads();
        unsigned r = base, tot = 0;
#pragma unroll
        for (int q = 0; q < 8; ++q) { const unsigned cq = sc[1 + q]; if (q < wq) r += cq; tot += cq; }
        r += (unsigned)__popcll(m & ((1ull << lane) - 1ull));
        if (eq && r < need) out[ngt + r] = (unsigned short)s;
        base += tot;
        __syncthreads();
    }
}
__device__ __forceinline__ void nv_dsa_attn(KArgs& a, unsigned char* lds, int t, int wv) {
    const bf16_t* q = (const bf16_t*)(a.ws + WS_Q0); const bf16_t* k = (const bf16_t*)(a.ws + WS_K0); const bf16_t* v = (const bf16_t*)(a.ws + WS_V0);
    const unsigned short* idx = (const unsigned short*)(a.ws + WS_IDX); bf16_t* y = (bf16_t*)(a.ws + WS_Y0);
    LAS float* p = lptr<float>(lds, 72 * 1024);
    LAS float* qs = lptr<float>(lds, 80 * 1024);
    LAS int* sid = lptr<int>(lds, 82 * 1024);
    LAS float* red = lptr<float>(lds, 83 * 1024);
    const int tid = tid_opaque(wv);
    const int N = (t / 64 + 1) * 64, cnt = N < TOPK ? N : TOPK;
    qs[tid] = bf2f(q[(size_t)t * 512 + tid]);
    int id = 0;
    if (tid < 256) { id = tid < cnt ? (int)idx[(size_t)t * TOPK + tid] : 0; sid[tid] = id; }
    __syncthreads();
    if (tid < cnt) {
        const float dist = fabsf((float)(t - id));
        const uint4* kp = (const uint4*)(k + (size_t)id * 512);
#pragma unroll
        for (int h = 0; h < 8; ++h) {
            float d = 0.f;
#pragma unroll
            for (int j = 0; j < 8; ++j) d += dot8q(qs + h * 64 + j * 8, kp[h * 8 + j]);
            p[h * 256 + tid] = d - exp2f(-(float)(h + 1)) * dist;
        }
    }
    __syncthreads();
    if (tid < 8) {
        float m = -3.0e38f;
        for (int j = 0; j < cnt; ++j) m = fmaxf(m, p[tid * 256 + j]);
        float s = 0.f;
        for (int j = 0; j < cnt; ++j) s += __expf(p[tid * 256 + j] - m);
        red[tid * 2] = m; red[tid * 2 + 1] = 1.f / s;
    }
    __syncthreads();
    if (tid < cnt) {
#pragma unroll
        for (int h = 0; h < 8; ++h) p[h * 256 + tid] = __expf(p[h * 256 + tid] - red[h * 2]) * red[h * 2 + 1];
    }
    __syncthreads();
    {
        const int c = tid, h = c >> 6;
        float acc = 0.f;
        for (int j = 0; j < cnt; ++j) acc += p[h * 256 + j] * bf2f(v[(size_t)sid[j] * 512 + c]);
        y[(size_t)t * 1024 + c] = f2bf(acc);
    }
}
__device__ __forceinline__ void ph_ffn_fix(const bf16_t* hu, const float* cw, bf16_t* g, int bid, int nb, int wv) {
    for (int gid = bid * NT + tid_opaque(wv); gid < 256 * 2 * DFF; gid += nb * NT) {
        const int j = gid % DFF, br = gid / DFF, rho = br & 1, blk = br >> 1, t = blk * 64 + rho;
        const int nv = 256 * (j >> 7) + (j & 127), ng = nv + 128;
        const bf16_t* cur = hu + (size_t)blk * 4 * DFF2; const bf16_t* prv = hu + (size_t)(blk > 0 ? blk - 1 : 0) * 4 * DFF2;
        const float u0v = bf2f(cur[rho * DFF2 + nv]), u0g = bf2f(cur[rho * DFF2 + ng]);
        float u1v, u1g, u2v, u2g;
        if (rho == 0) { u1v = blk > 0 ? bf2f(prv[3 * DFF2 + nv]) : 0.f; u1g = blk > 0 ? bf2f(prv[3 * DFF2 + ng]) : 0.f; u2v = blk > 0 ? bf2f(prv[2 * DFF2 + nv]) : 0.f; u2g = blk > 0 ? bf2f(prv[2 * DFF2 + ng]) : 0.f; }
        else          { u1v = bf2f(cur[nv]); u1g = bf2f(cur[ng]); u2v = blk > 0 ? bf2f(prv[3 * DFF2 + nv]) : 0.f; u2g = blk > 0 ? bf2f(prv[3 * DFF2 + ng]) : 0.f; }
        const float val = cw[j] * u2v + cw[DFF2 + j] * u1v + cw[2 * DFF2 + j] * u0v;
        const float gat = cw[DFF + j] * u2g + cw[DFF2 + DFF + j] * u1g + cw[2 * DFF2 + DFF + j] * u0g;
        g[(size_t)t * DFF + j] = f2bf(silu_f(gat) * val);
    }
}
__device__ __forceinline__ void nv_ffn_up(const bf16_t* xb, const bf16_t* wup, const float* bias, const float* cw, bf16_t* g, int bid, int nb, int wv) {
    const int vb = tid_opaque(wv) >> 8, tl = tid_opaque(wv) & 255;
    for (int it = bid * 2 + vb; it < 11 * (S / 8); it += nb * 2) {
        const int j = (it % 11) * 256 + tl, t0 = (it / 11) * 8;
        const int nv = 256 * (j >> 7) + (j & 127), ng = nv + 128;
        float uv[10], ug[10];
#pragma unroll
        for (int i = 0; i < 10; ++i) { uv[i] = 0.f; ug[i] = 0.f; }
        const bf16_t* wv = wup + (size_t)nv * D; const bf16_t* wg = wup + (size_t)ng * D;
        for (int k = 0; k < D; k += 8) {
            const uint4 av = *(const uint4*)(wv + k), bv = *(const uint4*)(wg + k);
#pragma unroll
            for (int i = 0; i < 10; ++i) {
                int r = t0 - 2 + i; if (r < 0) r = 0;
                const uint4 x = *(const uint4*)(xb + (size_t)r * D + k);
                uv[i] += dot8(x, av); ug[i] += dot8(x, bv);
            }
        }
        const float bvv = bias[nv], bgt = bias[ng];
#pragma unroll
        for (int i = 0; i < 10; ++i) { const bool ok = (t0 - 2 + i) >= 0; uv[i] = ok ? uv[i] + bvv : 0.f; ug[i] = ok ? ug[i] + bgt : 0.f; }
        const float cv0 = cw[j], cv1 = cw[DFF2 + j], cv2 = cw[2 * DFF2 + j];
        const float cg0 = cw[DFF + j], cg1 = cw[DFF2 + DFF + j], cg2 = cw[2 * DFF2 + DFF + j];
#pragma unroll
        for (int i = 0; i < 8; ++i) {
            const float val = cv0 * uv[i] + cv1 * uv[i + 1] + cv2 * uv[i + 2];
            const float gat = cg0 * ug[i] + cg1 * ug[i + 1] + cg2 * ug[i + 2];
            g[(size_t)(t0 + i) * DFF + j] = f2bf(silu_f(gat) * val);
        }
    }
}
__device__ __forceinline__ void ph_l1_prep(KArgs& a, int bid, int nb, int wv) {
    const bf16_t* z1 = (const bf16_t*)(a.ws + WS_Z1); const float* rope = (const float*)(a.ws + WS_ROPE);
    bf16_t* pl = (bf16_t*)(a.ws + WS_PL); float* rs = (float*)(a.ws + WS_RS); bf16_t* kr = (bf16_t*)(a.ws + WS_KR);
    const int lane = tid_opaque(wv) & 63, wave = tid_opaque(wv) >> 6;
    for (int t = bid * 8 + wave; t < S; t += nb * 8) {
        const bf16_t* zr = z1 + (size_t)t * ODD_IN_P;
        {
            const int c0 = lane * 8, win = 2 << (lane >> 4);
            const int lo = (t + 1 - win) > 0 ? (t + 1 - win) : 0;
            float sm[8];
#pragma unroll
            for (int e = 0; e < 8; ++e) sm[e] = 0.f;
            for (int r = lo; r <= t; ++r) {
                const uint4 u = *(const uint4*)(z1 + (size_t)r * ODD_IN_P + c0);
                sm[0] += bflo(u.x); sm[1] += bfhi(u.x); sm[2] += bflo(u.y); sm[3] += bfhi(u.y); sm[4] += bflo(u.z); sm[5] += bfhi(u.z); sm[6] += bflo(u.w); sm[7] += bfhi(u.w);
            }
            const float ic = 1.f / (float)(t + 1 - lo);
            const uint4 u = *(const uint4*)(zr + c0);
            uint4 o; o.x = pk2(sm[0] * ic - bflo(u.x), sm[1] * ic - bfhi(u.x)); o.y = pk2(sm[2] * ic - bflo(u.y), sm[3] * ic - bfhi(u.y));
            o.z = pk2(sm[4] * ic - bflo(u.z), sm[5] * ic - bfhi(u.z)); o.w = pk2(sm[6] * ic - bflo(u.w), sm[7] * ic - bfhi(u.w));
            *(uint4*)(pl + (size_t)t * 512 + c0) = o;
        }
        {
            float sq = 0.f;
#pragma unroll
            for (int j = 0; j < 3; ++j) { const unsigned u = *(const unsigned*)(zr + 512 + 128 * j + lane * 2); sq += bflo(u) * bflo(u) + bfhi(u) * bfhi(u); }
            sq = wave_sum(sq);
            const uint2 u2 = *(const uint2*)(zr + 896 + lane * 4);
            float sk = bflo(u2.x) * bflo(u2.x) + bfhi(u2.x) * bfhi(u2.x) + bflo(u2.y) * bflo(u2.y) + bfhi(u2.y) * bfhi(u2.y);
            sk = wave_sum(sk);
            if (lane == 0) { rs[(size_t)t * 2] = 1.f / sqrtf(sq * (1.f / 384.f) + RMS_EPS); rs[(size_t)t * 2 + 1] = 1.f / sqrtf(sk * (1.f / 256.f) + RMS_EPS); }
        }
        if (lane < 16) {
            const float x1 = bf2f(zr[1152 + lane]), x2 = bf2f(zr[1168 + lane]);
            const float c = rope[(size_t)t * 16 + lane], s = rope[(size_t)S * 16 + (size_t)t * 16 + lane];
            *(unsigned*)(kr + (size_t)t * 32 + 2 * lane) = pk2(x1 * c - x2 * s, x2 * c + x1 * s);
        }
    }
}
__device__ __forceinline__ void nv_mla(KArgs& a, unsigned char* lds, int t, int h, int wv) {
    const bf16_t* q1 = (const bf16_t*)(a.ws + WS_Q1); const bf16_t* k1 = (const bf16_t*)(a.ws + WS_K1); const bf16_t* kr = (const bf16_t*)(a.ws + WS_KR);
    const bf16_t* vt = (const bf16_t*)(a.ws + WS_VT); bf16_t* y = (bf16_t*)(a.ws + WS_Y1);
    LAS float* lg = lptr<float>(lds, 0);
    LAS float* qs = lptr<float>(lds, 65536);
    LAS float* red = lptr<float>(lds, 65536 + 512);
    const int tid = tid_opaque(wv), lane = tid & 63, wq = tid >> 6;
    const int N = (t / 64 + 1) * 64;
    if (tid < 96) qs[tid] = bf2f(q1[(size_t)t * 768 + h * 96 + tid]);
    __syncthreads();
    float m = -3.0e38f;
    for (int s = tid; s < N; s += NT) {
        asm volatile("" ::: "memory");
        const uint4* kp = (const uint4*)(k1 + (size_t)s * 512 + h * 64);
        float d = 0.f;
#pragma unroll
        for (int j = 0; j < 8; ++j) d += dot8q(qs + j * 8, kp[j]);
        const uint4* rp = (const uint4*)(kr + (size_t)s * 32);
#pragma unroll
        for (int j = 0; j < 4; ++j) d += dot8q(qs + 64 + j * 8, rp[j]);
        lg[s] = d; m = fmaxf(m, d);
    }
    m = wave_max(m);
    if (lane == 0) red[wq] = m;
    __syncthreads();
    m = red[0];
#pragma unroll
    for (int q = 1; q < 8; ++q) m = fmaxf(m, red[q]);
    __syncthreads();
    float sum = 0.f;
    for (int s = tid; s < N; s += NT) { const float pp = exp2f(lg[s] - m); lg[s] = pp; sum += pp; }
    sum = wave_sum(sum);
    if (lane == 0) red[wq] = sum;
    __syncthreads();
    float tot = 0.f;
#pragma unroll
    for (int q = 0; q < 8; ++q) tot += red[q];
    const float inv = 1.f / tot;
    for (int dd = 0; dd < 8; ++dd) {
        const int d = wq * 8 + dd;
        const bf16_t* vp = vt + (size_t)(h * 64 + d) * S;
        float acc = 0.f;
        for (int s = lane; s < N; s += 64) acc += lg[s] * bf2f(vp[s]);
        acc = wave_sum(acc);
        if (lane == 0) y[(size_t)t * 1024 + 512 + h * 64 + d] = f2bf(acc * inv);
    }
    __syncthreads();
}

typedef short mla_bf16x8 __attribute__((ext_vector_type(8)));
typedef float mla_f32x16 __attribute__((ext_vector_type(16)));
typedef float mla_f32x2 __attribute__((ext_vector_type(2)));
typedef __bf16 mla_bf16x2 __attribute__((ext_vector_type(2)));
typedef unsigned u32x4v __attribute__((ext_vector_type(4)));
typedef unsigned u32x2v __attribute__((ext_vector_type(2)));
constexpr int MLA_KSTR = 208, MLA_VSTR = 136, MLA_KBUF = 64 * MLA_KSTR, MLA_BUF = MLA_KBUF + 64 * MLA_VSTR;
__device__ __forceinline__ unsigned cvt2bf(float lo, float hi) { mla_f32x2 v = {lo, hi}; return __builtin_bit_cast(unsigned, __builtin_convertvector(v, mla_bf16x2)); }
__device__ __forceinline__ void mla_unit(const bf16_t* __restrict__ q1, const bf16_t* __restrict__ k1, const bf16_t* __restrict__ kr, const bf16_t* __restrict__ vt, bf16_t* __restrict__ y,
                                         unsigned char* lds, int h, int qb, int wv) {
    const int tid = tid_opaque(wv), lane = tid & 63, w = tid >> 6, l31 = lane & 31, hh = lane >> 5;
    LAS unsigned char* L = lptr<unsigned char>(lds, 0);
    const int tq = 256 * qb + 32 * w + l31;
    mla_bf16x8 qf[6];
#pragma unroll
    for (int ks = 0; ks < 6; ++ks) qf[ks] = *(const mla_bf16x8*)(q1 + (size_t)tq * 768 + h * 96 + ks * 16 + 8 * hh);
    const int ntiles = 4 * qb + 4, mytiles = 4 * qb + (w >> 1) + 1;
    const int rk = tid >> 3, ck = tid & 7, rr = (tid & 255) >> 2, cr = tid & 3;
    const bf16_t* gk = k1 + (size_t)rk * 512 + h * 64 + ck * 8;
    const bf16_t* gr = kr + (size_t)rr * 32 + cr * 8;
    const bf16_t* gv = vt + (size_t)(h * 64 + rk) * S + ck * 8;
    const int dk = rk * MLA_KSTR + ck * 16, dr = rr * MLA_KSTR + 128 + cr * 16, dv = MLA_KBUF + rk * MLA_VSTR + ck * 16;
    u32x4v sk, sr, sv;
    sk = *(const u32x4v*)gk; sv = *(const u32x4v*)gv; if (tid < 256) sr = *(const u32x4v*)gr;
    *(LAS u32x4v*)(L + dk) = sk; if (tid < 256) *(LAS u32x4v*)(L + dr) = sr;
    *(LAS u32x2v*)(L + dv) = (u32x2v){sv[0], sv[1]}; *(LAS u32x2v*)(L + dv + 8) = (u32x2v){sv[2], sv[3]};
    __syncthreads();
    mla_f32x16 o0, o1;
#pragma unroll
    for (int r = 0; r < 16; ++r) { o0[r] = 0.f; o1[r] = 0.f; }
    float m = -1.0e30f, l = 0.f;
    for (int j = 0; j < ntiles; ++j) {
        const bool more = (j + 1 < ntiles);
        if (more) {
            const size_t s0 = (size_t)(j + 1) * 64;
            sk = *(const u32x4v*)(gk + s0 * 512); sv = *(const u32x4v*)(gv + s0); if (tid < 256) sr = *(const u32x4v*)(gr + s0 * 32);
        }
        if (j < mytiles) {
            const LAS unsigned char* Kb = L + (j & 1) * MLA_BUF; const LAS unsigned char* Vb = Kb + MLA_KBUF;
            mla_f32x16 s0v, s1v;
#pragma unroll
            for (int r = 0; r < 16; ++r) { s0v[r] = 0.f; s1v[r] = 0.f; }
#pragma unroll
            for (int ks = 0; ks < 6; ++ks) {
                const mla_bf16x8 a0 = *(const LAS mla_bf16x8*)(Kb + l31 * MLA_KSTR + (ks * 16 + 8 * hh) * 2);
                const mla_bf16x8 a1 = *(const LAS mla_bf16x8*)(Kb + (32 + l31) * MLA_KSTR + (ks * 16 + 8 * hh) * 2);
                s0v = __builtin_amdgcn_mfma_f32_32x32x16_bf16(a0, qf[ks], s0v, 0, 0, 0);
                s1v = __builtin_amdgcn_mfma_f32_32x32x16_bf16(a1, qf[ks], s1v, 0, 0, 0);
            }
            float mx = fmaxf(s0v[0], s1v[0]);
#pragma unroll
            for (int r = 1; r < 16; ++r) mx = fmaxf(mx, fmaxf(s0v[r], s1v[r]));
            mx = fmaxf(mx, __shfl_xor(mx, 32));
            const float mn = fmaxf(m, mx), alpha = __builtin_amdgcn_exp2f(m - mn);
            m = mn;
            float rs = 0.f;
#pragma unroll
            for (int r = 0; r < 16; ++r) { s0v[r] = __builtin_amdgcn_exp2f(s0v[r] - mn); s1v[r] = __builtin_amdgcn_exp2f(s1v[r] - mn); rs += s0v[r] + s1v[r]; }
            l = l * alpha + rs;
#pragma unroll
            for (int r = 0; r < 16; ++r) { o0[r] *= alpha; o1[r] *= alpha; }
#pragma unroll
            for (int kb = 0; kb < 2; ++kb)
#pragma unroll
                for (int sx = 0; sx < 2; ++sx) {
                    u32x4v pw;
                    if (kb == 0) { pw[0] = cvt2bf(s0v[8 * sx + 0], s0v[8 * sx + 1]); pw[1] = cvt2bf(s0v[8 * sx + 2], s0v[8 * sx + 3]); pw[2] = cvt2bf(s0v[8 * sx + 4], s0v[8 * sx + 5]); pw[3] = cvt2bf(s0v[8 * sx + 6], s0v[8 * sx + 7]); }
                    else         { pw[0] = cvt2bf(s1v[8 * sx + 0], s1v[8 * sx + 1]); pw[1] = cvt2bf(s1v[8 * sx + 2], s1v[8 * sx + 3]); pw[2] = cvt2bf(s1v[8 * sx + 4], s1v[8 * sx + 5]); pw[3] = cvt2bf(s1v[8 * sx + 6], s1v[8 * sx + 7]); }
                    const mla_bf16x8 pb = __builtin_bit_cast(mla_bf16x8, pw);
                    const int kbase = (32 * kb + 16 * sx + 4 * hh) * 2;
                    {   const u32x2v lo = *(const LAS u32x2v*)(Vb + l31 * MLA_VSTR + kbase), hi = *(const LAS u32x2v*)(Vb + l31 * MLA_VSTR + kbase + 16);
                        u32x4v aw = {lo[0], lo[1], hi[0], hi[1]};
                        o0 = __builtin_amdgcn_mfma_f32_32x32x16_bf16(__builtin_bit_cast(mla_bf16x8, aw), pb, o0, 0, 0, 0); }
                    {   const u32x2v lo = *(const LAS u32x2v*)(Vb + (32 + l31) * MLA_VSTR + kbase), hi = *(const LAS u32x2v*)(Vb + (32 + l31) * MLA_VSTR + kbase + 16);
                        u32x4v aw = {lo[0], lo[1], hi[0], hi[1]};
                        o1 = __builtin_amdgcn_mfma_f32_32x32x16_bf16(__builtin_bit_cast(mla_bf16x8, aw), pb, o1, 0, 0, 0); }
                }
        }
        if (more) {
            LAS unsigned char* Nb = L + ((j + 1) & 1) * MLA_BUF;
            *(LAS u32x4v*)(Nb + dk) = sk; if (tid < 256) *(LAS u32x4v*)(Nb + dr) = sr;
            *(LAS u32x2v*)(Nb + dv) = (u32x2v){sv[0], sv[1]}; *(LAS u32x2v*)(Nb + dv + 8) = (u32x2v){sv[2], sv[3]};
        }
        __syncthreads();
    }
    l += __shfl_xor(l, 32);
    const float inv = 1.f / l;
    bf16_t* yo = y + (size_t)tq * 1024 + 512 + h * 64 + 4 * hh;
#pragma unroll
    for (int g4 = 0; g4 < 4; ++g4) {
        uint2 w0, w1;
        w0.x = cvt2bf(o0[4 * g4] * inv, o0[4 * g4 + 1] * inv); w0.y = cvt2bf(o0[4 * g4 + 2] * inv, o0[4 * g4 + 3] * inv);
        w1.x = cvt2bf(o1[4 * g4] * inv, o1[4 * g4 + 1] * inv); w1.y = cvt2bf(o1[4 * g4 + 2] * inv, o1[4 * g4 + 3] * inv);
        *(uint2*)(yo + 8 * g4) = w0; *(uint2*)(yo + 32 + 8 * g4) = w1;
    }
}
__device__ __forceinline__ void ph_mla(KArgs& a, unsigned char* lds, int bid, int nb, int wv) {
    const bf16_t* q1 = (const bf16_t*)(a.ws + WS_Q1); const bf16_t* k1 = (const bf16_t*)(a.ws + WS_K1); const bf16_t* kr = (const bf16_t*)(a.ws + WS_KR);
    const bf16_t* vt = (const bf16_t*)(a.ws + WS_VT); bf16_t* y = (bf16_t*)(a.ws + WS_Y1);
    for (int u = bid; u < 256; u += nb) {
        const int h = u & 7, qbp = u >> 3;
        mla_unit(q1, k1, kr, vt, y, lds, h, qbp, wv);
        mla_unit(q1, k1, kr, vt, y, lds, h, 63 - qbp, wv);
    }
}

constexpr int N_PHASES = 20;
__global__ void __launch_bounds__(NT, 2) mega(Args  ) {
    extern __shared__ __attribute__((aligned(16))) unsigned char lds[];
    const int wv = __builtin_amdgcn_readfirstlane((int)threadIdx.x >> 6);
    const int tid = tid_opaque(wv), bid = blockIdx.x, nb = gridDim.x;
    for (int u = tid; u < (LDS_BYTES - LDSCTL_OFF) / 4; u += NT) ((LAS unsigned*)((LAS unsigned char*)lds + LDSCTL_OFF))[u] = 0u;
    __syncthreads();
    volatile LAS unsigned* MISC = (volatile LAS unsigned*)((LAS unsigned char*)lds + MISC_OFF);
    const int ph_lo = kargs().ph_lo, ph_hi = kargs().ph_hi;
    XcdBarrier bar = xcd_barrier_post((unsigned*)(kargs().ws + WS_CTL) + CW_BAR, MISC + 8, wv);
#define IN(k) (ph_lo <= (k) && (k) < ph_hi)
#define SEAM(k) do { if (ph_lo <= (k) && (k) + 1 < ph_hi) xcd_barrier(bar); } while (0)
#define WSP(T, off) ((T*)(ws + (off)))

    if (IN(0)) { KArgs& a = kargs(); ph_mod(a, lds, bid, nb, wv); }
    SEAM(0);
    if (IN(1)) { KArgs& a = kargs(); ph_prep(a, lds, bid, nb, wv); }
    SEAM(1);
    if (IN(2)) { KArgs& a = kargs(); unsigned char* ws = a.ws;
        run_gemm(lds, WSP(const bf16_t, WS_XB), D, WSP(const bf16_t, WS_W_IN0), D, S, EVEN_IN_P, D,
                 EpiIn0{WSP(const float, WS_BIAS_IN0), WSP(bf16_t, WS_Q0), WSP(bf16_t, WS_K0), WSP(bf16_t, WS_V0), WSP(bf16_t, WS_BG), WSP(bf16_t, WS_CG), WSP(bf16_t, WS_XC),
                        WSP(f16_t, WS_QI), WSP(f16_t, WS_KI), WSP(float, WS_WI)}, nb, bid, wv); }
    SEAM(2);
    if (IN(3)) { KArgs& a = kargs();
        ph_shortconv(a, bid, nb, wv);
        for (int t = bid; t < S; t += nb) { nv_topk(a, lds, t, wv); __syncthreads(); nv_dsa_attn(a, lds, t, wv); __syncthreads(); }
    }
    SEAM(3);
    if (IN(4)) { KArgs& a = kargs(); unsigned char* ws = a.ws;
        run_gemm(lds, WSP(const bf16_t, WS_Y0), D, WSP(const bf16_t, WS_W_OUT0), D, S, D, D, EpiResid{a.x, a.out}, nb, bid, wv); }
    SEAM(4);
    if (IN(5)) { KArgs& a = kargs(); ph_ln(a.out, a.ln_mix_g, a.ln_mix_b, (bf16_t*)(a.ws + WS_XB), bid, nb, wv); }
    SEAM(5);
    if (IN(6)) { KArgs& a = kargs(); unsigned char* ws = a.ws;
        run_gemm_epi(lds, WSP(const bf16_t, WS_XB), D, WSP(const bf16_t, WS_W_UP0), D, S, DFF2, D, EpiFfnUp{WSP(const float, WS_BIAS_UP0), a.ffn_conv_w, WSP(bf16_t, WS_G), WSP(bf16_t, WS_HU)}, nb, bid, wv); }
    SEAM(6);
    if (IN(7)) { KArgs& a = kargs(); unsigned char* ws = a.ws; ph_ffn_fix(WSP(const bf16_t, WS_HU), a.ffn_conv_w, WSP(bf16_t, WS_G), bid, nb, wv); }
    SEAM(7);
    if (IN(8)) { KArgs& a = kargs(); unsigned char* ws = a.ws;
        run_gemm(lds, WSP(const bf16_t, WS_G), DFF, WSP(const bf16_t, WS_W_DN0), DFF, S, D, DFF, EpiResid{a.out, a.out}, nb, bid, wv); }
    SEAM(8);
    if (IN(9)) { KArgs& a = kargs(); ph_ln(a.out, a.ln_ffn_g, a.ln_ffn_b, (bf16_t*)(a.ws + WS_XB), bid, nb, wv); }
    SEAM(9);
    if (IN(10)) { KArgs& a = kargs(); unsigned char* ws = a.ws;
        run_gemm(lds, WSP(const bf16_t, WS_XB), D, WSP(const bf16_t, WS_W_IN1), D, S, ODD_IN_P, D, EpiBiasBf16{WSP(const float, WS_BIAS_IN1), WSP(bf16_t, WS_Z1), ODD_IN_P}, nb, bid, wv); }
    SEAM(10);
    if (IN(11)) { KArgs& a = kargs(); ph_l1_prep(a, bid, nb, wv); }
    SEAM(11);
    if (IN(12)) {
        { KArgs& a = kargs(); unsigned char* ws = a.ws;
          run_gemm(lds, WSP(const bf16_t, WS_PL), 512, WSP(const bf16_t, WS_W_POOL), 512, S, 512, 512, EpiPlainBf16{WSP(bf16_t, WS_Y1), 1024}, nb, bid, wv); }
        { KArgs& a = kargs(); unsigned char* ws = a.ws;
          run_gemm(lds, WSP(const bf16_t, WS_Z1) + 512, ODD_IN_P, WSP(const bf16_t, WS_W_UQ), 384, S, 768, 384, EpiQ1{WSP(const float, WS_RS), WSP(const float, WS_ROPE), WSP(bf16_t, WS_Q1)}, nb, bid, wv); }
        { KArgs& a = kargs(); unsigned char* ws = a.ws;
          run_gemm(lds, WSP(const bf16_t, WS_Z1) + 896, ODD_IN_P, WSP(const bf16_t, WS_W_UK), 256, S, 512, 256, EpiRowScaleBf16{WSP(const float, WS_RS), 1, WSP(bf16_t, WS_K1), 512}, nb, bid, wv); }
        { KArgs& a = kargs(); unsigned char* ws = a.ws;
          run_gemm(lds, WSP(const bf16_t, WS_W_UV), 256, WSP(const bf16_t, WS_Z1) + 896, ODD_IN_P, 512, S, 256, EpiColScaleBf16{WSP(const float, WS_RS), 1, WSP(bf16_t, WS_VT), S}, nb, bid, wv); }
    }
    SEAM(12);
    if (IN(13)) { KArgs& a = kargs(); ph_mla(a, lds, bid, nb, wv); }
    SEAM(13);
    if (IN(14)) { KArgs& a = kargs(); unsigned char* ws = a.ws;
        run_gemm(lds, WSP(const bf16_t, WS_Y1), D, WSP(const bf16_t, WS_W_OUT1), D, S, D, D, EpiResid{a.out, a.out}, nb, bid, wv); }
    SEAM(14);
    if (IN(15)) { KArgs& a = kargs(); ph_ln(a.out, a.ln_mix_g + D, a.ln_mix_b + D, (bf16_t*)(a.ws + WS_XB), bid, nb, wv); }
    SEAM(15);
    if (IN(16)) { KArgs& a = kargs(); unsigned char* ws = a.ws;
        run_gemm_epi(lds, WSP(const bf16_t, WS_XB), D, WSP(const bf16_t, WS_W_UP1), D, S, DFF2, D, EpiFfnUp{WSP(const float, WS_BIAS_UP1), a.ffn_conv_w + (size_t)3 * DFF2, WSP(bf16_t, WS_G), WSP(bf16_t, WS_HU)}, nb, bid, wv); }
    SEAM(16);
    if (IN(17)) { KArgs& a = kargs(); unsigned char* ws = a.ws; ph_ffn_fix(WSP(const bf16_t, WS_HU), a.ffn_conv_w + (size_t)3 * DFF2, WSP(bf16_t, WS_G), bid, nb, wv); }
    SEAM(17);
    if (IN(18)) { KArgs& a = kargs(); unsigned char* ws = a.ws;
        run_gemm(lds, WSP(const bf16_t, WS_G), DFF, WSP(const bf16_t, WS_W_DN1), DFF, S, D, DFF, EpiResid{a.out, a.out}, nb, bid, wv); }
    SEAM(18);
    if (IN(19)) { KArgs& a = kargs(); ph_ln(a.out, a.ln_ffn_g + D, a.ln_ffn_b + D, (bf16_t*)(a.ws + WS_XB), bid, nb, wv); }
#undef IN
#undef SEAM
#undef WSP
}

extern "C" void kernel_launch(void* const* d_in, const int* in_sizes, int n_in, void* d_out, int out_size, void* d_ws, size_t ws_size, hipStream_t stream) {
    static int grid = 0;
    if (grid == 0) {
        if (n_in != 22 || out_size != S * D || ws_size < WS_END) { fprintf(stderr, "kernel_launch: unexpected problem (n_in %d out %d ws %zu)\n", n_in, out_size, ws_size); grid = -1; return; }
        int dev = 0, cus = 0;
        if (hipGetDevice(&dev) != hipSuccess || hipDeviceGetAttribute(&cus, hipDeviceAttributeMultiprocessorCount, dev) != hipSuccess) { grid = -1; return; }
        if (hipFuncSetAttribute((const void*)mega, hipFuncAttributeMaxDynamicSharedMemorySize, LDS_BYTES) != hipSuccess) { fprintf(stderr, "kernel_launch: hipFuncSetAttribute failed\n"); grid = -1; return; }
        grid = cus;
    }
    if (grid < 0) return;
    if (hipMemsetAsync((char*)d_ws + WS_CTL, 0, CTL_ZERO_BYTES, stream) != hipSuccess) return;
    Args a{};
    const float** ap = (const float**)&a;
    for (int i = 0; i < 22; ++i) ap[i] = (const float*)d_in[i];
    a.out = (float*)d_out; a.ws = (unsigned char*)d_ws;
#if MK_SPLIT
    for (int p = 0; p < N_PHASES; ++p) { a.ph_lo = p; a.ph_hi = p + 1; hipLaunchKernelGGL(mega, dim3(grid), dim3(NT), LDS_BYTES, stream, a); }
#else
    a.ph_lo = 0; a.ph_hi = N_PHASES;
    hipLaunchKernelGGL(mega, dim3(grid), dim3(NT), LDS_BYTES, stream, a);
#endif
}
```

```cpp
#include <hip/hip_runtime.h>
#include <cstdint>
#include <cstdio>

typedef unsigned short bf16_t;
typedef _Float16 f16_t;

#ifndef MK_SPLIT
#define MK_SPLIT 0
#endif

constexpr int S = 16384, D = 1024;
constexpr int EVEN_IN = 3656, EVEN_IN_P = 3840;
constexpr int ODD_IN = 1184, ODD_IN_P = 1280;
constexpr int DFF = 2816, DFF2 = 5632;
constexpr int TOPK = 256;
constexpr float DN_ALPHA = 1.41421356237309515f;
constexpr float LN_EPS = 1e-5f, RMS_EPS = 1e-6f;
constexpr float MLA_QSCALE = 0.14724444602590306f;
constexpr int NT = 512;

constexpr size_t MiB = 1u << 20;
constexpr size_t WS_CTL = 0, CTL_ZERO_BYTES = 1 * MiB;
constexpr size_t WS_MOD = 1 * MiB;
constexpr size_t WS_BIAS_IN0 = 1 * MiB + 64 * 1024;
constexpr size_t WS_BIAS_UP0 = 1 * MiB + 96 * 1024;
constexpr size_t WS_BIAS_IN1 = 1 * MiB + 128 * 1024;
constexpr size_t WS_BIAS_UP1 = 1 * MiB + 160 * 1024;
constexpr size_t WS_RS = 1 * MiB + 256 * 1024;
constexpr size_t WS_ROPE = 2 * MiB;
constexpr size_t WS_W_IN0 = 4 * MiB;
constexpr size_t WS_W_OUT0 = 12 * MiB;
constexpr size_t WS_W_UP0 = 14 * MiB;
constexpr size_t WS_W_DN0 = 25 * MiB;
constexpr size_t WS_W_IN1 = 31 * MiB;
constexpr size_t WS_W_POOL = 34 * MiB;
constexpr size_t WS_W_UQ = 35 * MiB;
constexpr size_t WS_W_UK = 36 * MiB;
constexpr size_t WS_W_UV = 36 * MiB + 512 * 1024;
constexpr size_t WS_W_OUT1 = 37 * MiB;
constexpr size_t WS_W_UP1 = 39 * MiB;
constexpr size_t WS_W_DN1 = 50 * MiB;
constexpr size_t WS_XB = 56 * MiB;
constexpr size_t WS_Q0 = 88 * MiB, WS_K0 = 104 * MiB, WS_V0 = 120 * MiB;
constexpr size_t WS_QI = 136 * MiB;
constexpr size_t WS_BG = 152 * MiB, WS_CG = 168 * MiB, WS_XC = 184 * MiB;
constexpr size_t WS_KI = 200 * MiB;
constexpr size_t WS_WI = 202 * MiB;
constexpr size_t WS_IDX = 203 * MiB;
constexpr size_t WS_Y0 = 212 * MiB;
constexpr size_t WS_G = 88 * MiB;
constexpr size_t WS_HU = 176 * MiB;
constexpr size_t WS_Z1 = 88 * MiB;
constexpr size_t WS_PL = 128 * MiB;
constexpr size_t WS_Q1 = 144 * MiB;
constexpr size_t WS_K1 = 168 * MiB;
constexpr size_t WS_KR = 184 * MiB;
constexpr size_t WS_VT = 186 * MiB;
constexpr size_t WS_Y1 = 202 * MiB;
constexpr size_t WS_END = 256 * MiB;

constexpr int CW_BAR = 4096;

constexpr int RING_BYTES = 131072;
constexpr int LDSCTL_OFF = RING_BYTES, MISC_OFF = LDSCTL_OFF + 320;
constexpr int LDS_BYTES = 147456;

#define GAS __attribute__((address_space(1)))
#define LAS __attribute__((address_space(3)))
typedef GAS unsigned gu32;
#define LDS_WAIT() asm volatile("s_waitcnt lgkmcnt(0)" ::: "memory")
__device__ __forceinline__ float bf2f(bf16_t h) { return __uint_as_float(((unsigned)h) << 16); }
__device__ __forceinline__ bf16_t f2bf(float f) { unsigned u = __float_as_uint(f); return (bf16_t)((u + 0x7fffu + ((u >> 16) & 1u)) >> 16); }
__device__ __forceinline__ unsigned pk2(float lo, float hi) { return (unsigned)f2bf(lo) | ((unsigned)f2bf(hi) << 16); }
__device__ __forceinline__ float bflo(unsigned w) { return __uint_as_float(w << 16); }
__device__ __forceinline__ float bfhi(unsigned w) { return __uint_as_float(w & 0xffff0000u); }
__device__ __forceinline__ float h2f_lo(unsigned w) { return (float)__builtin_bit_cast(_Float16, (unsigned short)(w & 0xffffu)); }
__device__ __forceinline__ float h2f_hi(unsigned w) { return (float)__builtin_bit_cast(_Float16, (unsigned short)(w >> 16)); }
__device__ __forceinline__ float wave_sum(float v) {
#pragma unroll
    for (int o = 1; o < 64; o <<= 1) v += __shfl_xor(v, o);
    return v;
}
__device__ __forceinline__ float wave_max(float v) {
#pragma unroll
    for (int o = 1; o < 64; o <<= 1) v = fmaxf(v, __shfl_xor(v, o));
    return v;
}
__device__ __forceinline__ float silu_f(float v) { return v / (1.f + __expf(-v)); }
__device__ __forceinline__ float dot8(const uint4 a, const uint4 b) {
    return bflo(a.x) * bflo(b.x) + bfhi(a.x) * bfhi(b.x) + bflo(a.y) * bflo(b.y) + bfhi(a.y) * bfhi(b.y)
         + bflo(a.z) * bflo(b.z) + bfhi(a.z) * bfhi(b.z) + bflo(a.w) * bflo(b.w) + bfhi(a.w) * bfhi(b.w);
}
template <class P> __device__ __forceinline__ float dot8q(P q, const uint4 u) {
    return q[0] * bflo(u.x) + q[1] * bfhi(u.x) + q[2] * bflo(u.y) + q[3] * bfhi(u.y) + q[4] * bflo(u.z) + q[5] * bfhi(u.z) + q[6] * bflo(u.w) + q[7] * bfhi(u.w);
}

__device__ __forceinline__ int hw_lane() { unsigned z = 0u; asm volatile("" : "+s"(z)); return (int)__builtin_amdgcn_mbcnt_hi(~0u, __builtin_amdgcn_mbcnt_lo(~0u, z)); }
__device__ __forceinline__ int tid_opaque(int wv) { int t = (wv << 6) | hw_lane(); asm volatile("" : "+v"(t)); return t; }
template <class T> __device__ __forceinline__ LAS T* lptr(unsigned char* lds, int off) {
    unsigned b = (unsigned)(uintptr_t)((LAS unsigned char*)lds + off);
    asm volatile("" : "+s"(b));
    return (LAS T*)(uintptr_t)b;
}
__constant__ float c_inv_freq[16] = {1.0f, 0.5623413324356079f, 0.3162277638912201f, 0.17782793939113617f, 0.10000000149011612f, 0.05623413249850273f,
    0.03162277489900589f, 0.017782794311642647f, 0.009999999776482582f, 0.005623413249850273f, 0.003162277629598975f, 0.0017782794311642647f,
    0.0010000000474974513f, 0.000562341301701963f, 0.0003162277571391314f, 0.00017782794020604342f};

namespace pg8 {
#define PG8_LAS __attribute__((address_space(3)))
typedef unsigned short bf16_t;
typedef short bf16x8 __attribute__((ext_vector_type(8)));
typedef float f32x4 __attribute__((ext_vector_type(4)));
typedef unsigned u32x4 __attribute__((ext_vector_type(4)));
constexpr int BM = 256, BK = 64, HALF = 128, HTB = HALF * BK * 2  , STAGE_BYTES = 8 * HTB, NXCD = 8, WGM = 8;

__host__ __device__ __forceinline__ int lds_byte(int r, int c) { const int st = (r >> 4) * 2 + (c >> 5), rr = r & 15, cc = c & 31, ob = rr * 64 + cc * 2; return st * 1024 + (ob ^ (((ob >> 9) & 1) << 5)); }
__host__ __device__ __forceinline__ void stage_rc(int b, int& R, int& C) { const int st = b / 1024, sb = b % 1024, swz = sb ^ (((sb >> 9) & 1) << 5); R = (st >> 1) * 16 + swz / 64; C = (st & 1) * 32 + (swz % 64) / 2; }
__host__ __device__ __forceinline__ int perm32(int rho) { const int n = rho >> 4, i = rho & 15; return 8 * (i >> 2) + 4 * n + (i & 3); }

struct Unit { int pm, pn; };
struct Gemm { const bf16_t* A; const bf16_t* Bt; int M, N, K, lda, ldb; };

struct StaticOrder {
    int nM, nN, nwg, G, c;
    __host__ __device__ void init(int M, int N, int G_, int c_) { nM = M / BM; nN = N / BM; nwg = nM * nN; G = G_; c = c_; }
    __host__ __device__ bool next(int i, Unit& u) const {
        const long L = (long)i * G + c; if (L >= nwg) return false;
        int wgid = (int)L; { const int q = nwg / NXCD, r = nwg % NXCD, xcd = wgid % NXCD, off = wgid / NXCD; wgid = (xcd < r ? xcd * (q + 1) : r * (q + 1) + (xcd - r) * q) + off; }
        const int nig = WGM * nN, gid = wgid / nig, fm = gid * WGM, gsz = (nM - fm) < WGM ? (nM - fm) : WGM;
        u.pm = fm + ((wgid % nig) % gsz); u.pn = (wgid % nig) / gsz; return true;
    }
    __device__ __forceinline__ void a_ready(const Unit&) const {}
    __device__ __forceinline__ void done(const Unit&) const {}
};

__device__ __forceinline__ unsigned cvt_pk_bf16(float lo, float hi) { unsigned r; asm volatile("v_cvt_pk_bf16_f32 %0, %1, %2" : "=v"(r) : "v"(lo), "v"(hi)); return r; }
template <class Epi, class Sched, bool ALIGN_EPI = false, bool SP2 = false>
__device__ __forceinline__ void gemm_phase(PG8_LAS unsigned char* lds, const Gemm g, const Sched& S, const Epi& E, int wv_in) {
    unsigned z_ = 0u; asm volatile("" : "+s"(z_)); int tid = (wv_in << 6) | (int)__builtin_amdgcn_mbcnt_hi(~0u, __builtin_amdgcn_mbcnt_lo(~0u, z_)); asm volatile("" : "+v"(tid)); const int wid = __builtin_amdgcn_readfirstlane(tid >> 6), lane = tid & 63, wr = wid >> 2, wc = wid & 3, fr = lane & 15, fq = lane >> 4;
    const int K = g.K, nt = K / BK;
    unsigned voffA[2], voffB[2];
#pragma unroll
    for (int i = 0; i < 2; ++i) { int R, C; stage_rc(tid * 16 + i * 8192, R, C); const int Rb = Epi::PERM ? ((R & ~31) + perm32(R & 31)) : R;
        voffA[i] = (unsigned)(R * g.lda + C) * 2u; voffB[i] = (unsigned)(Rb * g.ldb + C) * 2u; }
    const size_t kstep = (size_t)(BK * 2);
    const size_t hstepA = (size_t)HALF * g.lda * 2, hstepB = (size_t)HALF * g.ldb * 2;
    const size_t tstepA = 2 * hstepA, tstepB = 2 * hstepB;
    const unsigned ldsw = (unsigned)wid * 1024u;
    const int aoff = lds_byte(wr * 64 + fr, fq * 8), boff = lds_byte(wc * 32 + fr, fq * 8);
#define PG8_SA(b, h) (((b) * 2 + (h)) * HTB)
#define PG8_SB(b, h) ((4 + (b) * 2 + (h)) * HTB)
#define PG8_STAGE(bufoff, gbase, voff) do { _Pragma("unroll") for (int _i = 0; _i < 2; ++_i) \
        __builtin_amdgcn_global_load_lds((const unsigned*)((const char*)(gbase) + (voff)[_i]), (PG8_LAS unsigned*)(lds + (bufoff) + ldsw + _i * 8192), 16, 0, 0); } while (0)
#define PG8_LDA(dst, b, h) do { _Pragma("unroll") for (int m = 0; m < 4; ++m) _Pragma("unroll") for (int k = 0; k < 2; ++k) dst[m][k] = *(const PG8_LAS bf16x8*)(lds + PG8_SA(b, h) + aoff + m * 2048 + k * 1024); } while (0)
#define PG8_LDB(dst, b, h) do { _Pragma("unroll") for (int n = 0; n < 2; ++n) _Pragma("unroll") for (int k = 0; k < 2; ++k) dst[n][k] = *(const PG8_LAS bf16x8*)(lds + PG8_SB(b, h) + boff + n * 2048 + k * 1024); } while (0)
#define PG8_MMA(ai, bj, At, Bt) do { __builtin_amdgcn_s_setprio(1); _Pragma("unroll") for (int m = 0; m < 4; ++m) _Pragma("unroll") for (int n = 0; n < 2; ++n) _Pragma("unroll") for (int k = 0; k < 2; ++k) \
        acc[ai][bj][m][n] = __builtin_amdgcn_mfma_f32_16x16x32_bf16(Bt[n][k], At[m][k], acc[ai][bj][m][n], 0, 0, 0); __builtin_amdgcn_s_setprio(0); } while (0)
#define PG8_WAIT_V(n) asm volatile("s_waitcnt vmcnt(" #n ")" ::: "memory")
#define PG8_WAIT_L(n) asm volatile("s_waitcnt lgkmcnt(" #n ")" ::: "memory")
#define PG8_BAR __builtin_amdgcn_s_barrier()
#define PG8_SCHED __builtin_amdgcn_sched_barrier(0)
    Unit cur, nxt; int ui = 0;
    if (!S.next(0, cur)) return;
    f32x4 acc[2][2][4][2];
#pragma unroll
    for (int a = 0; a < 2; ++a)
#pragma unroll
        for (int b = 0; b < 2; ++b)
#pragma unroll
            for (int m = 0; m < 4; ++m)
#pragma unroll
                for (int n = 0; n < 2; ++n) acc[a][b][m][n] = (f32x4){0.f, 0.f, 0.f, 0.f};
    bf16x8 At[4][2], B0[2][2], B1[2][2];
    const char* cA = (const char*)g.A + (size_t)cur.pm * tstepA; const char* cB = (const char*)g.Bt + (size_t)cur.pn * tstepB;
    S.a_ready(cur);
    if constexpr (SP2) {
        PG8_STAGE(PG8_SB(0, 0), cB, voffB); PG8_STAGE(PG8_SB(0, 1), cB + hstepB, voffB); PG8_STAGE(PG8_SA(0, 0), cA, voffA); PG8_STAGE(PG8_SA(0, 1), cA + hstepA, voffA);
        if (wr == 1) PG8_BAR;
        PG8_WAIT_V(2); PG8_BAR;
        PG8_STAGE(PG8_SB(1, 0), cB + kstep, voffB); PG8_STAGE(PG8_SA(1, 0), cA + kstep, voffA); PG8_STAGE(PG8_SB(1, 1), cB + hstepB + kstep, voffB);
        PG8_WAIT_V(6); PG8_BAR;
    } else {
        PG8_STAGE(PG8_SB(0, 0), cB, voffB); PG8_STAGE(PG8_SA(0, 0), cA, voffA); PG8_STAGE(PG8_SB(0, 1), cB + hstepB, voffB); PG8_STAGE(PG8_SA(0, 1), cA + hstepA, voffA);
        if (wr == 1) PG8_BAR;
        PG8_WAIT_V(4); PG8_BAR;
        PG8_STAGE(PG8_SB(1, 0), cB + kstep, voffB); PG8_STAGE(PG8_SA(1, 0), cA + kstep, voffA); PG8_STAGE(PG8_SB(1, 1), cB + hstepB + kstep, voffB);
        PG8_WAIT_V(6); PG8_BAR;
    }
    for (;;) {
        const bool has_next = S.next(ui + 1, nxt);
        const char* nA = has_next ? (const char*)g.A + (size_t)nxt.pm * tstepA : cA; const char* nB = has_next ? (const char*)g.Bt + (size_t)nxt.pn * tstepB : cB;
        for (int t = 0; t < nt; t += 2) {
            const bool last = (t == nt - 2);
            const char* a1 = cA + (size_t)(t + 1) * kstep;
            const char* a2 = last ? nA : cA + (size_t)(t + 2) * kstep; const char* b2 = last ? nB : cB + (size_t)(t + 2) * kstep;
            const char* a3 = a2 + kstep; const char* b3 = b2 + kstep;
            if (last && has_next) S.a_ready(nxt);
            if constexpr (SP2) {
            PG8_LDB(B0, 0, 0); PG8_LDB(B1, 0, 1); PG8_SCHED; PG8_LDA(At, 0, 0); PG8_STAGE(PG8_SA(1, 1), a1 + hstepA, voffA);
            PG8_WAIT_V(8); PG8_WAIT_L(0); PG8_BAR; PG8_MMA(0, 0, At, B0); PG8_MMA(0, 1, At, B1); PG8_BAR; PG8_SCHED;
            PG8_LDA(At, 0, 1); PG8_STAGE(PG8_SB(0, 0), b2, voffB); PG8_STAGE(PG8_SB(0, 1), b2 + hstepB, voffB); PG8_STAGE(PG8_SA(0, 0), a2, voffA);
            PG8_WAIT_V(8); PG8_WAIT_L(0); PG8_BAR; PG8_MMA(1, 0, At, B0); PG8_MMA(1, 1, At, B1); PG8_BAR; PG8_SCHED;
            PG8_LDB(B0, 1, 0); PG8_LDB(B1, 1, 1); PG8_SCHED; PG8_LDA(At, 1, 0); PG8_STAGE(PG8_SA(0, 1), a2 + hstepA, voffA);
            PG8_WAIT_V(8); PG8_WAIT_L(0); PG8_BAR; PG8_MMA(0, 0, At, B0); PG8_MMA(0, 1, At, B1); PG8_BAR; PG8_SCHED;
            PG8_LDA(At, 1, 1); PG8_STAGE(PG8_SB(1, 0), b3, voffB); PG8_STAGE(PG8_SB(1, 1), b3 + hstepB, voffB); PG8_STAGE(PG8_SA(1, 0), a3, voffA);
            PG8_WAIT_V(8); PG8_WAIT_L(0); PG8_BAR; PG8_MMA(1, 0, At, B0); PG8_MMA(1, 1, At, B1); PG8_BAR; PG8_SCHED;
            } else {
            PG8_LDB(B0, 0, 0); PG8_SCHED; PG8_LDA(At, 0, 0); PG8_STAGE(PG8_SA(1, 1), a1 + hstepA, voffA);
            PG8_WAIT_L(8); PG8_BAR; PG8_WAIT_L(0); PG8_MMA(0, 0, At, B0); PG8_BAR; PG8_SCHED;
            PG8_LDB(B1, 0, 1); PG8_STAGE(PG8_SB(0, 0), b2, voffB);
            PG8_BAR; PG8_WAIT_L(0); PG8_MMA(0, 1, At, B1); PG8_BAR;
            PG8_LDA(At, 0, 1); PG8_STAGE(PG8_SA(0, 0), a2, voffA);
            PG8_BAR; PG8_WAIT_L(0); PG8_MMA(1, 0, At, B0); PG8_BAR; PG8_SCHED;
            PG8_STAGE(PG8_SB(0, 1), b2 + hstepB, voffB);
            PG8_WAIT_V(6); PG8_BAR; PG8_MMA(1, 1, At, B1); PG8_BAR;
            PG8_LDB(B0, 1, 0); PG8_SCHED; PG8_LDA(At, 1, 0); PG8_STAGE(PG8_SA(0, 1), a2 + hstepA, voffA);
            PG8_WAIT_L(8); PG8_BAR; PG8_WAIT_L(0); PG8_MMA(0, 0, At, B0); PG8_BAR; PG8_SCHED;
            PG8_LDB(B1, 1, 1); PG8_STAGE(PG8_SB(1, 0), b3, voffB);
            PG8_BAR; PG8_WAIT_L(0); PG8_MMA(0, 1, At, B1); PG8_BAR;
            PG8_LDA(At, 1, 1); PG8_STAGE(PG8_SA(1, 0), a3, voffA);
            PG8_BAR; PG8_WAIT_L(0); PG8_MMA(1, 0, At, B0); PG8_BAR; PG8_SCHED;
            PG8_STAGE(PG8_SB(1, 1), b3 + hstepB, voffB);
            PG8_WAIT_V(6); PG8_BAR; PG8_MMA(1, 1, At, B1); PG8_BAR;
            }
        }
        if constexpr (ALIGN_EPI) { if (wr == 0) PG8_BAR; }
        if constexpr (!Epi::AFTER_DRAIN) { E(acc, cur, wr, wc, fr, fq); S.done(cur); }
        if (!has_next) break;
#pragma unroll
        for (int a = 0; a < 2; ++a)
#pragma unroll
            for (int b = 0; b < 2; ++b)
#pragma unroll
                for (int m = 0; m < 4; ++m)
#pragma unroll
                    for (int n = 0; n < 2; ++n) acc[a][b][m][n] = (f32x4){0.f, 0.f, 0.f, 0.f};
        cur = nxt; cA = nA; cB = nB; ++ui;
        if constexpr (ALIGN_EPI) { if (wr == 1) PG8_BAR; }
    }
    PG8_WAIT_V(0);
    if constexpr (!ALIGN_EPI) { if (wr == 0) PG8_BAR; }
    PG8_BAR;
    if constexpr (Epi::AFTER_DRAIN) { E.fused(acc, cur, wr, wc, fr, fq, lds, wid, lane); S.done(cur); }
#undef PG8_SA
#undef PG8_SB
#undef PG8_STAGE
#undef PG8_LDA
#undef PG8_LDB
#undef PG8_MMA
#undef PG8_WAIT_V
#undef PG8_WAIT_L
#undef PG8_BAR
#undef PG8_SCHED
}
}


#define XB_TMO      128
#define XB_XCNT(j)  (256  + 64 * (j))
#define XB_XSUB(j)  (1280 + 64 * (j))
#define XB_XGEN(j)  (2304 + 64 * (j))
#define XB_TOP      3328
#define XB_TOPGEN   3392
#define XCD_BAR_WORDS 3456
#define XB_SPIN_CAP (1u << 18)

__device__ __forceinline__ unsigned xb_ld(unsigned* p)              { return __hip_atomic_load(p, __ATOMIC_RELAXED, __HIP_MEMORY_SCOPE_AGENT); }
__device__ __forceinline__ unsigned xb_add(unsigned* p, unsigned v) { return __hip_atomic_fetch_add(p, v, __ATOMIC_RELAXED, __HIP_MEMORY_SCOPE_AGENT); }
__device__ __forceinline__ unsigned xb_xcc_id() { return (unsigned)__builtin_amdgcn_s_getreg((3 << 11) | 20) & 0xFu; }
#define XB_SPIN(cond, bar) do { unsigned _sp = 0; while (cond) { __builtin_amdgcn_s_sleep(1); \
    if ((++_sp & 255u) == 0u) { if (xb_ld(&(bar)[XB_TMO])) break; if (_sp > XB_SPIN_CAP) { atomicAdd(&(bar)[XB_TMO], 1u); break; } } } } while (0)

struct XcdBarrier {
    unsigned* bar; unsigned x; int wv;
    volatile LAS unsigned* st;
};

__device__ __forceinline__ XcdBarrier xcd_barrier_post(unsigned* bar, volatile LAS unsigned* st, int wv) {
    XcdBarrier b; b.bar = bar; b.x = xb_xcc_id(); b.st = st;
    b.wv = wv; if (wv == 0 && hw_lane() == 0) (void)xb_add(&bar[XB_XCNT(b.x)], 1u);
    return b;
}
__device__ __forceinline__ void xcd_barrier_complete(unsigned* bar, unsigned x, unsigned& nloc, unsigned& nx) {
    const unsigned G = gridDim.x * gridDim.y * gridDim.z;
    unsigned sum, cnt, mine, sp = 0u;
    for (;;) {
        sum = 0u; cnt = 0u; mine = 0u;
#pragma unroll
        for (unsigned j = 0; j < 16; ++j) { const unsigned c = xb_ld(&bar[XB_XCNT(j)]); sum += c; cnt += (c > 0u) ? 1u : 0u; mine = (j == x) ? c : mine; }
        if (sum == G) break;
        __builtin_amdgcn_s_sleep(1);
        if ((++sp & 255u) == 0u) { if (xb_ld(&bar[XB_TMO])) break; if (sp > XB_SPIN_CAP) { atomicAdd(&bar[XB_TMO], 1u); break; } }
    }
    nloc = mine > 0u ? mine : 1u; nx = cnt > 0u ? cnt : 1u;
}

__device__ __forceinline__ void xcd_barrier(const XcdBarrier& b) {
    asm volatile("s_waitcnt vmcnt(0)" ::: "memory");
    __syncthreads();
    if (b.wv == 0 && hw_lane() == 0) {
        unsigned* bar = b.bar;
        __builtin_amdgcn_s_waitcnt(0);
        unsigned nloc = b.st[0], nx = b.st[1];
        if (nloc == 0u) { xcd_barrier_complete(bar, b.x, nloc, nx); b.st[0] = nloc; b.st[1] = nx; }
        const unsigned old = xb_add(&bar[XB_XSUB(b.x)], 1u);
        const unsigned gen = old / nloc;
        if (old + 1u == (gen + 1u) * nloc) {
            __builtin_amdgcn_fence(__ATOMIC_RELEASE, "agent");
            asm volatile("s_waitcnt vmcnt(0)" ::: "memory");
            const unsigned og = xb_add(&bar[XB_TOP], 1u);
            const unsigned tg = og / nx;
            if (og + 1u == (tg + 1u) * nx) xb_add(&bar[XB_TOPGEN], 1u);
            else XB_SPIN(xb_ld(&bar[XB_TOPGEN]) == tg, bar);
            __builtin_amdgcn_fence(__ATOMIC_ACQUIRE, "agent");
            xb_add(&bar[XB_XGEN(b.x)], 1u);
            asm volatile("s_waitcnt vmcnt(0)" ::: "memory");
        } else {
            XB_SPIN(xb_ld(&bar[XB_XGEN(b.x)]) == gen, bar);
            __builtin_amdgcn_fence(__ATOMIC_ACQUIRE, "agent");
            asm volatile("s_waitcnt vmcnt(0)" ::: "memory");
        }
    }
    __syncthreads();
}


struct Args {
    const float *x, *c, *ada_w, *ada_b, *ln_mix_g, *ln_mix_b, *ln_ffn_g, *ln_ffn_b, *ev_w_in, *ev_conv_w, *ev_w_out, *od_w_in, *pool_w, *pool_scale,
                *q_norm_g, *w_uq, *kv_norm_g, *w_ukv, *od_w_out, *ffn_w_up, *ffn_conv_w, *ffn_w_down;
    float* out; unsigned char* ws; int ph_lo, ph_hi;
};

#define AS4 __attribute__((address_space(4)))
typedef const AS4 Args KArgs;
__device__ __forceinline__ KArgs& kargs() { unsigned z = 0; asm volatile("" : "+s"(z)); return *(KArgs*)((const AS4 char*)__builtin_amdgcn_kernarg_segment_ptr() + z); }

__device__ __forceinline__ void st_bf16x4(bf16_t* p, float a, float b, float c, float d) { uint2 w; w.x = pk2(a, b); w.y = pk2(c, d); *(uint2*)p = w; }
struct EpiIn0 {
    const float* bias; bf16_t *q, *k, *v, *bg, *cg, *xc; f16_t *qi, *ki; float* wi;
    __device__ __forceinline__ void store4(int r, int c, float a, float b, float cc, float d) const {
        if (c >= EVEN_IN) return;
        const float4 bv = *(const float4*)(bias + c); a += bv.x; b += bv.y; cc += bv.z; d += bv.w;
        if (c < 512) { st_bf16x4(q + (size_t)r * 512 + c, a * 0.125f, b * 0.125f, cc * 0.125f, d * 0.125f); return; }
        if (c < 1024) { st_bf16x4(k + (size_t)r * 512 + (c - 512), a, b, cc, d); return; }
        if (c < 1536) { st_bf16x4(v + (size_t)r * 512 + (c - 1024), a, b, cc, d); return; }
        if (c < 2048) { f16_t* p = qi + (size_t)r * 512 + (c - 1536); p[0] = (f16_t)a; p[1] = (f16_t)b; p[2] = (f16_t)cc; p[3] = (f16_t)d; return; }
        if (c < 2112) { f16_t* p = ki + (size_t)r * 64 + (c - 2048); p[0] = (f16_t)a; p[1] = (f16_t)b; p[2] = (f16_t)cc; p[3] = (f16_t)d; return; }
        if (c < 2120) { *(float4*)(wi + (size_t)r * 8 + (c - 2112)) = make_float4(a, b, cc, d); return; }
        if (c < 2632) { st_bf16x4(bg + (size_t)r * 512 + (c - 2120), a, b, cc, d); return; }
        if (c < 3144) { st_bf16x4(cg + (size_t)r * 512 + (c - 2632), a, b, cc, d); return; }
        st_bf16x4(xc + (size_t)r * 512 + (c - 3144), a, b, cc, d);
    }
};
struct EpiResid {
    const float* res; float* pre;
    __device__ __forceinline__ void store4(int r, int c, float a, float b, float cc, float d) const {
        const float4 x = *(const float4*)(res + (size_t)r * D + c);
        *(float4*)(pre + (size_t)r * D + c) = make_float4(DN_ALPHA * x.x + a, DN_ALPHA * x.y + b, DN_ALPHA * x.z + cc, DN_ALPHA * x.w + d);
    }
};
struct EpiBiasBf16 {
    const float* bias; bf16_t* out; int ldc;
    __device__ __forceinline__ void store4(int r, int c, float a, float b, float cc, float d) const {
        const float4 bv = *(const float4*)(bias + c);
        st_bf16x4(out + (size_t)r * ldc + c, a + bv.x, b + bv.y, cc + bv.z, d + bv.w);
    }
};
struct EpiPlainBf16 {
    bf16_t* out; int ldc;
    __device__ __forceinline__ void store4(int r, int c, float a, float b, float cc, float d) const { st_bf16x4(out + (size_t)r * ldc + c, a, b, cc, d); }
};
struct EpiRowScaleBf16 {
    const float* rs; int which; bf16_t* out; int ldc;
    __device__ __forceinline__ void store4(int r, int c, float a, float b, float cc, float d) const {
        const float s = rs[(size_t)r * 2 + which]; st_bf16x4(out + (size_t)r * ldc + c, a * s, b * s, cc * s, d * s);
    }
};
struct EpiColScaleBf16 {
    const float* rs; int which; bf16_t* out; int ldc;
    __device__ __forceinline__ void store4(int r, int c, float a, float b, float cc, float d) const {
        st_bf16x4(out + (size_t)r * ldc + c, a * rs[(size_t)c * 2 + which], b * rs[(size_t)(c + 1) * 2 + which], cc * rs[(size_t)(c + 2) * 2 + which], d * rs[(size_t)(c + 3) * 2 + which]);
    }
};
struct EpiQ1 {
    const float* rs; const float* rope; bf16_t* out;
    __device__ __forceinline__ void store4(int r, int c, float a, float b, float cc, float d) const {
        const float s = rs[(size_t)r * 2]; a *= s; b *= s; cc *= s; d *= s;
        const int e = c % 96;
        if (e >= 64) {
            const int i = (e - 64) >> 1;
            const float c0 = rope[(size_t)r * 16 + i], s0 = rope[(size_t)S * 16 + (size_t)r * 16 + i];
            const float c1 = rope[(size_t)r * 16 + i + 1], s1 = rope[(size_t)S * 16 + (size_t)r * 16 + i + 1];
            const float a2 = a * c0 - b * s0, b2 = b * c0 + a * s0, c2 = cc * c1 - d * s1, d2 = d * c1 + cc * s1;
            a = a2; b = b2; cc = c2; d = d2;
        }
        st_bf16x4(out + (size_t)r * 768 + c, a, b, cc, d);
    }
};
template <class F> struct EpiFn {
    static constexpr bool PERM = true, AFTER_DRAIN = false;
    F f;
    __device__ __forceinline__ void operator()(const pg8::f32x4 (&acc)[2][2][4][2], const pg8::Unit& u, int wr, int wc, int fr, int fq) const {
        { int l = hw_lane(); asm volatile("" : "+v"(l)); fr = l & 15; fq = l >> 4; }
        const int row0 = u.pm * 256 + wr * 64 + fr, col0 = u.pn * 256 + wc * 32 + 8 * fq;
#pragma unroll
        for (int ai = 0; ai < 2; ++ai)
#pragma unroll
            for (int m = 0; m < 4; ++m)
#pragma unroll
                for (int bj = 0; bj < 2; ++bj)
#pragma unroll
                    for (int n = 0; n < 2; ++n) { const pg8::f32x4 v = acc[ai][bj][m][n]; f.store4(row0 + ai * 128 + m * 16, col0 + bj * 128 + 4 * n, v[0], v[1], v[2], v[3]);
                                                  asm volatile("" ::: "memory"); }
    }
};
template <class E>
__device__ __forceinline__ void run_gemm_epi(unsigned char* lds, const bf16_t* A, int lda, const bf16_t* Bt, int ldb, int M, int N, int K, const E& e, int nb, int bid, int wv) {
    asm volatile("" : "+s"(K), "+s"(lda), "+s"(ldb));
    pg8::Gemm g{A, Bt, M, N, K, lda, ldb}; pg8::StaticOrder So; So.init(M, N, nb, bid);
    pg8::gemm_phase<E, pg8::StaticOrder, true, true>((PG8_LAS unsigned char*)lds, g, So, e, wv);
}
template <class F>
__device__ __forceinline__ void run_gemm(unsigned char* lds, const bf16_t* A, int lda, const bf16_t* Bt, int ldb, int M, int N, int K, const F& f, int nb, int bid, int wv) {
    asm volatile("" : "+s"(K), "+s"(lda), "+s"(ldb));
    pg8::Gemm g{A, Bt, M, N, K, lda, ldb}; pg8::StaticOrder So; So.init(M, N, nb, bid);
    EpiFn<F> E{f};
    pg8::gemm_phase<EpiFn<F>, pg8::StaticOrder, true, true>((PG8_LAS unsigned char*)lds, g, So, E, wv);
}

template <int N> __device__ __forceinline__ float prev_row(float prevgroup, float cur) {
    const int t = __builtin_amdgcn_update_dpp(0, __builtin_bit_cast(int, prevgroup), 0x120 + N, 0xf, 0xf, true);
    return __builtin_bit_cast(float, __builtin_amdgcn_update_dpp(t, __builtin_bit_cast(int, cur), 0x110 + N, 0xf, 0xf, false));
}
struct EpiFfnUp {
    static constexpr bool PERM = true, AFTER_DRAIN = false;
    const float* bias; const float* cw; bf16_t* g; bf16_t* hu;
    template <int HALFSEL>
    __device__ __forceinline__ void half(const pg8::f32x4 (&acc)[2][2][4][2], int ai, int n, int fr, const float* bp, const float* cp, bf16_t* h01, bf16_t* h23, float (&o)[4][4]) const {
#pragma unroll
        for (int e = 0; e < 4; ++e) {
            const float be = bp[e], c0e = cp[e], c1e = cp[DFF2 + e], c2e = cp[2 * DFF2 + e];
            float uu[4];
#pragma unroll
            for (int m = 0; m < 4; ++m) uu[m] = acc[ai][HALFSEL][m][n][e] + be;
#pragma unroll
            for (int m = 0; m < 4; ++m) {
                const float p1 = prev_row<1>(uu[m > 0 ? m - 1 : 0], uu[m]), p2 = prev_row<2>(uu[m > 0 ? m - 1 : 0], uu[m]);
                const float cvv = c0e * p2 + c1e * p1 + c2e * uu[m];
                if (HALFSEL == 0) o[m][e] = cvv; else o[m][e] *= silu_f(cvv);
            }
            if (fr < 2) h01[HALFSEL * 128 + e] = f2bf(uu[0]);
            if (fr >= 14) h23[HALFSEL * 128 + e] = f2bf(uu[3]);
            asm volatile("" ::: "memory"); __builtin_amdgcn_sched_barrier(0);
        }
    }
    __device__ __forceinline__ void operator()(const pg8::f32x4 (&acc)[2][2][4][2], const pg8::Unit& u, int wr, int wc, int fr, int fq) const {
        { int l = hw_lane(); asm volatile("" : "+v"(l)); fr = l & 15; fq = l >> 4; }
        const int jl = wc * 32 + 8 * fq, j0 = u.pn * 128 + jl, nb0 = u.pn * 256 + jl;
#pragma unroll
        for (int n = 0; n < 2; ++n) {
#pragma unroll
            for (int ai = 0; ai < 2; ++ai) {
                const int row0 = u.pm * 256 + ai * 128 + wr * 64, blk = row0 >> 6;
                bf16_t* h01 = hu + ((size_t)blk * 4 + (fr & 1)) * DFF2 + nb0 + 4 * n;
                bf16_t* h23 = hu + ((size_t)blk * 4 + 2 + (fr & 1)) * DFF2 + nb0 + 4 * n;
                float o[4][4];
                half<0>(acc, ai, n, fr, bias + nb0 + 4 * n, cw + j0 + 4 * n, h01, h23, o);
                half<1>(acc, ai, n, fr, bias + nb0 + 128 + 4 * n, cw + DFF + j0 + 4 * n, h01, h23, o);
#pragma unroll
                for (int m = 0; m < 4; ++m) {
                    if (m > 0 || fr >= 2) st_bf16x4(g + (size_t)(row0 + 16 * m + fr) * DFF + j0 + 4 * n, o[m][0], o[m][1], o[m][2], o[m][3]);
                }
                asm volatile("" ::: "memory");
            }
        }
    }
};

__device__ __forceinline__ void ph_mod(KArgs& a, unsigned char* lds, int bid, int nb, int wv) {
    float* mod = (float*)(a.ws + WS_MOD);
    LAS float* red = lptr<float>(lds, 0);
    const int tid = tid_opaque(wv), lane = tid & 63, wave = tid >> 6;
    for (int it = bid; it < 192; it += nb) {
        const int n = it * 64 + lane, l = n / 6144, nn = n % 6144;
        const float* w = a.ada_w + (size_t)l * 1024 * 6144 + nn;
        float acc = 0.f;
        for (int k = wave * 128; k < wave * 128 + 128; ++k) acc += silu_f(a.c[k]) * w[(size_t)k * 6144];
        red[wave * 64 + lane] = acc;
        __syncthreads();
        if (wave == 0) { float s = 0.f;
#pragma unroll
            for (int q = 0; q < 8; ++q) s += red[q * 64 + lane];
            mod[n] = s + a.ada_b[n]; }
        __syncthreads();
    }
    float* rope = (float*)(a.ws + WS_ROPE);
    for (int gid = bid * NT + tid; gid < S * 16; gid += nb * NT) {
        const int t = gid >> 4, i = gid & 15;
        const float ang = (float)t * c_inv_freq[i];
        double rev = (double)ang * 0.15915494309189535;
        rev -= rint(rev);
        const float f = (float)rev;
        rope[gid] = __builtin_amdgcn_cosf(f);
        rope[S * 16 + gid] = __builtin_amdgcn_sinf(f);
    }
}
__device__ __forceinline__ int src_col(int mode, int n, int Nsrc) {
    if (mode == 0) return n < Nsrc ? n : -1;
    if (mode == 1) { const int tile = n >> 8, i = n & 255; return i < 128 ? tile * 128 + i : DFF + tile * 128 + (i - 128); }
    if (mode == 2) { const int h = n / 96, e = n % 96; if (e < 64) return h * 96 + e; const int i = (e - 64) >> 1; return h * 96 + 64 + ((e & 1) ? 16 + i : i); }
    if (mode == 3) { const int h = n >> 6, d = n & 63; return h * 128 + d; }
    { const int h = n >> 6, d = n & 63; return h * 128 + 64 + d; }
}
__device__ __forceinline__ void prep_item(const float* W, int K, int Nsrc, int Npad, int mode, const float* rs1p, const float* rs, const float* cs1p, float cst, bf16_t* dst,
                                          LAS float* scr, int item, int lane) {
    const int nblk = Npad / 32, kb = item / nblk, nbk = item % nblk, k0 = kb * 64, n0 = nbk * 32, nl = lane & 31;
    const int sn = src_col(mode, n0 + nl, Nsrc);
    float cs = cst; if (sn >= 0 && cs1p) cs *= 1.f + cs1p[sn];
#pragma unroll 8
    for (int i = 0; i < 32; ++i) {
        const int kk = 2 * i + (lane >> 5), k = k0 + kk;
        float v = 0.f;
        if (sn >= 0) { v = W[(size_t)k * Nsrc + sn] * cs; if (rs1p) v *= 1.f + rs1p[k]; if (rs) v *= rs[k]; }
        scr[kk * 33 + nl] = v;
    }
    LDS_WAIT();
    const int c = lane & 7;
#pragma unroll
    for (int j = 0; j < 4; ++j) {
        const int n = (lane >> 3) + 8 * j; const LAS float* s = scr + (8 * c) * 33 + n;
        uint4 o; o.x = pk2(s[0 * 33], s[1 * 33]); o.y = pk2(s[2 * 33], s[3 * 33]); o.z = pk2(s[4 * 33], s[5 * 33]); o.w = pk2(s[6 * 33], s[7 * 33]);
        *(uint4*)(dst + (size_t)(n0 + n) * K + k0 + 8 * c) = o;
    }
    LDS_WAIT();
}
__device__ __forceinline__ void bias_item(const float* W, int K, int Nsrc, int mode, const float* shift, float* bias, LAS float* red, int item, int wv) {
    const int tid = tid_opaque(wv), lane = tid & 63, wave = tid >> 6;
    const int n = item * 64 + lane, sn = src_col(mode, n, Nsrc), ks = K / 8;
    float acc = 0.f;
    if (sn >= 0) for (int k = wave * ks; k < wave * ks + ks; ++k) acc += shift[k] * W[(size_t)k * Nsrc + sn];
    red[wave * 64 + lane] = acc;
    __syncthreads();
    if (wave == 0) { float s = 0.f;
#pragma unroll
        for (int q = 0; q < 8; ++q) s += red[q * 64 + lane];
        bias[n] = s; }
    __syncthreads();
}
__device__ __forceinline__ void ph_prep(KArgs& a, unsigned char* lds, int bid, int nb, int wv) {
    const int tid = tid_opaque(wv), lane = tid & 63, wave = tid >> 6;
    unsigned char* ws = a.ws;
    const float* m0 = (const float*)(ws + WS_MOD); const float* m1 = m0 + 6144;
    {
        LAS float* red = lptr<float>(lds, 0);
        for (int it = bid; it < 256; it += nb) {
            int r = it;
            if (r < 60) { bias_item(a.ev_w_in, 1024, EVEN_IN, 0, m0, (float*)(ws + WS_BIAS_IN0), red, r, wv); continue; } r -= 60;
            if (r < 88) { bias_item(a.ffn_w_up, 1024, DFF2, 1, m0 + 3072, (float*)(ws + WS_BIAS_UP0), red, r, wv); continue; } r -= 88;
            if (r < 20) { bias_item(a.od_w_in, 1024, ODD_IN, 0, m1, (float*)(ws + WS_BIAS_IN1), red, r, wv); continue; } r -= 20;
            bias_item(a.ffn_w_up + (size_t)1024 * DFF2, 1024, DFF2, 1, m1 + 3072, (float*)(ws + WS_BIAS_UP1), red, r, wv);
        }
    }
    {
        LAS float* scr = lptr<float>(lds, 4096) + wave * 2176;
        const int gw = bid * 8 + wave, NGW = nb * 8;
        constexpr int I_IN0 = 16 * (EVEN_IN_P / 32), I_SQ = 16 * 32, I_UP = 16 * (DFF2 / 32), I_DN = 44 * 32, I_IN1 = 16 * (ODD_IN_P / 32), I_UQ = 6 * 24, I_UKV = 4 * 16;
        constexpr int NITEMS = I_IN0 + I_SQ + I_UP + I_DN + I_IN1 + I_UQ + 2 * I_UKV + I_SQ + I_UP + I_DN;
        for (int it = gw; it < NITEMS; it += NGW) {
            int r = it;
            if (r < I_IN0) { prep_item(a.ev_w_in, 1024, EVEN_IN, EVEN_IN_P, 0, m0 + 1024, nullptr, nullptr, 1.f, (bf16_t*)(ws + WS_W_IN0), scr, r, lane); continue; } r -= I_IN0;
            if (r < I_SQ) { prep_item(a.ev_w_out, 1024, 1024, 1024, 0, nullptr, nullptr, m0 + 2048, 1.f, (bf16_t*)(ws + WS_W_OUT0), scr, r, lane); continue; } r -= I_SQ;
            if (r < I_UP) { prep_item(a.ffn_w_up, 1024, DFF2, DFF2, 1, m0 + 4096, nullptr, nullptr, 1.f, (bf16_t*)(ws + WS_W_UP0), scr, r, lane); continue; } r -= I_UP;
            if (r < I_DN) { prep_item(a.ffn_w_down, DFF, 1024, 1024, 0, nullptr, nullptr, m0 + 5120, 1.f, (bf16_t*)(ws + WS_W_DN0), scr, r, lane); continue; } r -= I_DN;
            if (r < I_IN1) { prep_item(a.od_w_in, 1024, ODD_IN, ODD_IN_P, 0, m1 + 1024, nullptr, nullptr, 1.f, (bf16_t*)(ws + WS_W_IN1), scr, r, lane); continue; } r -= I_IN1;
            if (r < I_UQ) { prep_item(a.w_uq, 384, 768, 768, 2, nullptr, a.q_norm_g, nullptr, MLA_QSCALE, (bf16_t*)(ws + WS_W_UQ), scr, r, lane); continue; } r -= I_UQ;
            if (r < I_UKV) { prep_item(a.w_ukv, 256, 1024, 512, 3, nullptr, a.kv_norm_g, nullptr, 1.f, (bf16_t*)(ws + WS_W_UK), scr, r, lane); continue; } r -= I_UKV;
            if (r < I_UKV) { prep_item(a.w_ukv, 256, 1024, 512, 4, nullptr, a.kv_norm_g, nullptr, 1.f, (bf16_t*)(ws + WS_W_UV), scr, r, lane); continue; } r -= I_UKV;
            if (r < I_SQ) { prep_item(a.od_w_out, 1024, 1024, 1024, 0, nullptr, nullptr, m1 + 2048, 1.f, (bf16_t*)(ws + WS_W_OUT1), scr, r, lane); continue; } r -= I_SQ;
            if (r < I_UP) { prep_item(a.ffn_w_up + (size_t)1024 * DFF2, 1024, DFF2, DFF2, 1, m1 + 4096, nullptr, nullptr, 1.f, (bf16_t*)(ws + WS_W_UP1), scr, r, lane); continue; } r -= I_UP;
            prep_item(a.ffn_w_down + (size_t)DFF * 1024, DFF, 1024, 1024, 0, nullptr, nullptr, m1 + 5120, 1.f, (bf16_t*)(ws + WS_W_DN1), scr, r, lane);
        }
    }
    {
        bf16_t* dst = (bf16_t*)(ws + WS_W_POOL);
        for (int gid = bid * NT + tid; gid < 512 * 512; gid += nb * NT) {
            const int n = gid >> 9, k = gid & 511, g = n >> 7, d = n & 127;
            float v = 0.f;
            if ((k >> 7) == g) v = a.pool_w[((size_t)g * 128 + (k & 127)) * 128 + d] * a.pool_scale[n];
            dst[gid] = f2bf(v);
        }
    }
    {
        bf16_t* xb = (bf16_t*)(ws + WS_XB);
        for (int gid = bid * NT + tid; gid < S * D / 4; gid += nb * NT) {
            const float4 v = ((const float4*)a.x)[gid];
            st_bf16x4(xb + (size_t)gid * 4, v.x, v.y, v.z, v.w);
        }
    }
}
__device__ __forceinline__ void ph_ln(float* pre, const float* g, const float* b, bf16_t* xb, int bid, int nb, int wv) {
    const int lane = tid_opaque(wv) & 63, wave = tid_opaque(wv) >> 6;
    for (int row = bid * 8 + wave; row < S; row += nb * 8) {
        float4* xr = (float4*)(pre + (size_t)row * D) + lane;
        float4 v[4]; float s = 0.f;
#pragma unroll
        for (int j = 0; j < 4; ++j) { v[j] = xr[64 * j]; s += (v[j].x + v[j].y) + (v[j].z + v[j].w); }
        const float mean = wave_sum(s) * (1.f / D); float s2 = 0.f;
#pragma unroll
        for (int j = 0; j < 4; ++j) { v[j].x -= mean; v[j].y -= mean; v[j].z -= mean; v[j].w -= mean; s2 += (v[j].x * v[j].x + v[j].y * v[j].y) + (v[j].z * v[j].z + v[j].w * v[j].w); }
        const float rstd = 1.f / sqrtf(wave_sum(s2) * (1.f / D) + LN_EPS);
#pragma unroll
        for (int j = 0; j < 4; ++j) {
            const float4 gg = ((const float4*)g)[64 * j + lane], bb = ((const float4*)b)[64 * j + lane];
            float4 o; o.x = v[j].x * rstd * gg.x + bb.x; o.y = v[j].y * rstd * gg.y + bb.y; o.z = v[j].z * rstd * gg.z + bb.z; o.w = v[j].w * rstd * gg.w + bb.w;
            xr[64 * j] = o;
            st_bf16x4(xb + (size_t)row * D + (64 * j + lane) * 4, o.x, o.y, o.z, o.w);
        }
    }
}
__device__ __forceinline__ void ph_shortconv(KArgs& a, int bid, int nb, int wv) {
    const bf16_t* bg = (const bf16_t*)(a.ws + WS_BG); const bf16_t* cg = (const bf16_t*)(a.ws + WS_CG); const bf16_t* xc = (const bf16_t*)(a.ws + WS_XC);
    bf16_t* y = (bf16_t*)(a.ws + WS_Y0);
    for (int gid = bid * NT + tid_opaque(wv); gid < S * 64; gid += nb * NT) {
        const int t = gid >> 6, c0 = (gid & 63) * 8;
        float acc[8];
#pragma unroll
        for (int e = 0; e < 8; ++e) acc[e] = 0.f;
#pragma unroll
        for (int kk = 0; kk < 3; ++kk) {
            const int tt = t - 2 + kk;
            if (tt >= 0) {
                const uint4 cgv = *(const uint4*)(cg + (size_t)tt * 512 + c0), xv = *(const uint4*)(xc + (size_t)tt * 512 + c0);
                const float4 w0 = *(const float4*)(a.ev_conv_w + kk * 512 + c0), w1 = *(const float4*)(a.ev_conv_w + kk * 512 + c0 + 4);
                acc[0] += w0.x * bflo(cgv.x) * bflo(xv.x); acc[1] += w0.y * bfhi(cgv.x) * bfhi(xv.x);
                acc[2] += w0.z * bflo(cgv.y) * bflo(xv.y); acc[3] += w0.w * bfhi(cgv.y) * bfhi(xv.y);
                acc[4] += w1.x * bflo(cgv.z) * bflo(xv.z); acc[5] += w1.y * bfhi(cgv.z) * bfhi(xv.z);
                acc[6] += w1.z * bflo(cgv.w) * bflo(xv.w); acc[7] += w1.w * bfhi(cgv.w) * bfhi(xv.w);
            }
        }
        const uint4 b = *(const uint4*)(bg + (size_t)t * 512 + c0);
        uint4 o; o.x = pk2(bflo(b.x) * acc[0], bfhi(b.x) * acc[1]); o.y = pk2(bflo(b.y) * acc[2], bfhi(b.y) * acc[3]);
        o.z = pk2(bflo(b.z) * acc[4], bfhi(b.z) * acc[5]); o.w = pk2(bflo(b.w) * acc[6], bfhi(b.w) * acc[7]);
        *(uint4*)(y + (size_t)t * 1024 + 512 + c0) = o;
    }
}
__device__ __forceinline__ void nv_topk(KArgs& a, unsigned char* lds, int t, int wv) {
    const f16_t* qi = (const f16_t*)(a.ws + WS_QI); const f16_t* ki = (const f16_t*)(a.ws + WS_KI); const float* wi = (const float*)(a.ws + WS_WI);
    unsigned short* out = (unsigned short*)(a.ws + WS_IDX) + (size_t)t * TOPK;
    LAS unsigned* key = lptr<unsigned>(lds, 0);
    LAS float* qs = lptr<float>(lds, 65536);
    LAS unsigned* sc = lptr<unsigned>(lds, 65536 + 2048);
    const int tid = tid_opaque(wv), lane = tid & 63, wq = tid >> 6, N = (t / 64 + 1) * 64;
    if (N <= TOPK) { if (tid < N) out[tid] = (unsigned short)tid; return; }
    qs[tid] = (float)qi[(size_t)t * 512 + tid];
    float w[8];
#pragma unroll
    for (int h = 0; h < 8; ++h) w[h] = wi[(size_t)t * 8 + h];
    __syncthreads();
    for (int s = tid; s < N; s += NT) {
        asm volatile("" ::: "memory");
        const uint4* kp = (const uint4*)(ki + (size_t)s * 64);
        uint4 kq[8];
#pragma unroll
        for (int j = 0; j < 8; ++j) kq[j] = kp[j];
        float score = 0.f;
#pragma unroll
        for (int h = 0; h < 8; ++h) {
            float d = 0.f;
#pragma unroll
            for (int j = 0; j < 8; ++j) { const LAS float* q = qs + h * 64 + j * 8; const uint4 u = kq[j];
                d += q[0] * h2f_lo(u.x) + q[1] * h2f_hi(u.x) + q[2] * h2f_lo(u.y) + q[3] * h2f_hi(u.y) + q[4] * h2f_lo(u.z) + q[5] * h2f_hi(u.z) + q[6] * h2f_lo(u.w) + q[7] * h2f_hi(u.w); }
            score += w[h] * fmaxf(d, 0.f);
        }
        unsigned u = __float_as_uint(score); u = (u & 0x80000000u) ? ~u : (u | 0x80000000u);
        key[s] = u;
    }
    __syncthreads();
    unsigned T = 0;
    for (int bit = 31; bit >= 0; --bit) {
        const unsigned cand = T | (1u << bit);
        if (tid == 0) sc[0] = 0;
        __syncthreads();
        unsigned c = 0;
        for (int s = tid; s < N; s += NT) c += (key[s] >= cand) ? 1u : 0u;
        __hip_atomic_fetch_add(&sc[0], c, __ATOMIC_RELAXED, __HIP_MEMORY_SCOPE_WORKGROUP);
        __syncthreads();
        if (sc[0] >= (unsigned)TOPK) T = cand;
        __syncthreads();
    }
    if (tid == 0) sc[0] = 0;
    __syncthreads();
    for (int s = tid; s < N; s += NT) if (key[s] > T) { const unsigned p = __hip_atomic_fetch_add(&sc[0], 1u, __ATOMIC_RELAXED, __HIP_MEMORY_SCOPE_WORKGROUP); out[p] = (unsigned short)s; }
    __syncthreads();
    const unsigned ngt = sc[0], need = TOPK - ngt;
    __syncthreads();
    unsigned base = 0;
    for (int s0 = 0; s0 < N; s0 += NT) {
        const int s = s0 + tid;
        const bool eq = (s < N) && (key[s] == T);
        const unsigned long long m = __ballot(eq);
        if (lane == 0) sc[1 + wq] = (unsigned)__popcll(m);
        __syncthreads();
        unsigned r = base, tot = 0;
#pragma unroll
        for (int q = 0; q < 8; ++q) { const unsigned cq = sc[1 + q]; if (q < wq) r += cq; tot += cq; }
        r += (unsigned)__popcll(m & ((1ull << lane) - 1ull));
        if (eq && r < need) out[ngt + r] = (unsigned short)s;
        base += tot;
        __syncthreads();
    }
}
__device__ __forceinline__ void nv_dsa_attn(KArgs& a, unsigned char* lds, int t, int wv) {
    const bf16_t* q = (const bf16_t*)(a.ws + WS_Q0); const bf16_t* k = (const bf16_t*)(a.ws + WS_K0); const bf16_t* v = (const bf16_t*)(a.ws + WS_V0);
    const unsigned short* idx = (const unsigned short*)(a.ws + WS_IDX); bf16_t* y = (bf16_t*)(a.ws + WS_Y0);
    LAS float* p = lptr<float>(lds, 72 * 1024);
    LAS float* qs = lptr<float>(lds, 80 * 1024);
    LAS int* sid = lptr<int>(lds, 82 * 1024);
    LAS float* red = lptr<float>(lds, 83 * 1024);
    const int tid = tid_opaque(wv);
    const int N = (t / 64 + 1) * 64, cnt = N < TOPK ? N : TOPK;
    qs[tid] = bf2f(q[(size_t)t * 512 + tid]);
    int id = 0;
    if (tid < 256) { id = tid < cnt ? (int)idx[(size_t)t * TOPK + tid] : 0; sid[tid] = id; }
    __syncthreads();
    if (tid < cnt) {
        const float dist = fabsf((float)(t - id));
        const uint4* kp = (const uint4*)(k + (size_t)id * 512);
#pragma unroll
        for (int h = 0; h < 8; ++h) {
            float d = 0.f;
#pragma unroll
            for (int j = 0; j < 8; ++j) d += dot8q(qs + h * 64 + j * 8, kp[h * 8 + j]);
            p[h * 256 + tid] = d - exp2f(-(float)(h + 1)) * dist;
        }
    }
    __syncthreads();
    if (tid < 8) {
        float m = -3.0e38f;
        for (int j = 0; j < cnt; ++j) m = fmaxf(m, p[tid * 256 + j]);
        float s = 0.f;
        for (int j = 0; j < cnt; ++j) s += __expf(p[tid * 256 + j] - m);
        red[tid * 2] = m; red[tid * 2 + 1] = 1.f / s;
    }
    __syncthreads();
    if (tid < cnt) {
#pragma unroll
        for (int h = 0; h < 8; ++h) p[h * 256 + tid] = __expf(p[h * 256 + tid] - red[h * 2]) * red[h * 2 + 1];
    }
    __syncthreads();
    {
        const int c = tid, h = c >> 6;
        float acc = 0.f;
        for (int j = 0; j < cnt; ++j) acc += p[h * 256 + j] * bf2f(v[(size_t)sid[j] * 512 + c]);
        y[(size_t)t * 1024 + c] = f2bf(acc);
    }
}
__device__ __forceinline__ void ph_ffn_fix(const bf16_t* hu, const float* cw, bf16_t* g, int bid, int nb, int wv) {
    for (int gid = bid * NT + tid_opaque(wv); gid < 256 * 2 * DFF; gid += nb * NT) {
        const int j = gid % DFF, br = gid / DFF, rho = br & 1, blk = br >> 1, t = blk * 64 + rho;
        const int nv = 256 * (j >> 7) + (j & 127), ng = nv + 128;
        const bf16_t* cur = hu + (size_t)blk * 4 * DFF2; const bf16_t* prv = hu + (size_t)(blk > 0 ? blk - 1 : 0) * 4 * DFF2;
        const float u0v = bf2f(cur[rho * DFF2 + nv]), u0g = bf2f(cur[rho * DFF2 + ng]);
        float u1v, u1g, u2v, u2g;
        if (rho == 0) { u1v = blk > 0 ? bf2f(prv[3 * DFF2 + nv]) : 0.f; u1g = blk > 0 ? bf2f(prv[3 * DFF2 + ng]) : 0.f; u2v = blk > 0 ? bf2f(prv[2 * DFF2 + nv]) : 0.f; u2g = blk > 0 ? bf2f(prv[2 * DFF2 + ng]) : 0.f; }
        else          { u1v = bf2f(cur[nv]); u1g = bf2f(cur[ng]); u2v = blk > 0 ? bf2f(prv[3 * DFF2 + nv]) : 0.f; u2g = blk > 0 ? bf2f(prv[3 * DFF2 + ng]) : 0.f; }
        const float val = cw[j] * u2v + cw[DFF2 + j] * u1v + cw[2 * DFF2 + j] * u0v;
        const float gat = cw[DFF + j] * u2g + cw[DFF2 + DFF + j] * u1g + cw[2 * DFF2 + DFF + j] * u0g;
        g[(size_t)t * DFF + j] = f2bf(silu_f(gat) * val);
    }
}
__device__ __forceinline__ void nv_ffn_up(const bf16_t* xb, const bf16_t* wup, const float* bias, const float* cw, bf16_t* g, int bid, int nb, int wv) {
    const int vb = tid_opaque(wv) >> 8, tl = tid_opaque(wv) & 255;
    for (int it = bid * 2 + vb; it < 11 * (S / 8); it += nb * 2) {
        const int j = (it % 11) * 256 + tl, t0 = (it / 11) * 8;
        const int nv = 256 * (j >> 7) + (j & 127), ng = nv + 128;
        float uv[10], ug[10];
#pragma unroll
        for (int i = 0; i < 10; ++i) { uv[i] = 0.f; ug[i] = 0.f; }
        const bf16_t* wv = wup + (size_t)nv * D; const bf16_t* wg = wup + (size_t)ng * D;
        for (int k = 0; k < D; k += 8) {
            const uint4 av = *(const uint4*)(wv + k), bv = *(const uint4*)(wg + k);
#pragma unroll
            for (int i = 0; i < 10; ++i) {
                int r = t0 - 2 + i; if (r < 0) r = 0;
                const uint4 x = *(const uint4*)(xb + (size_t)r * D + k);
                uv[i] += dot8(x, av); ug[i] += dot8(x, bv);
            }
        }
        const float bvv = bias[nv], bgt = bias[ng];
#pragma unroll
        for (int i = 0; i < 10; ++i) { const bool ok = (t0 - 2 + i) >= 0; uv[i] = ok ? uv[i] + bvv : 0.f; ug[i] = ok ? ug[i] + bgt : 0.f; }
        const float cv0 = cw[j], cv1 = cw[DFF2 + j], cv2 = cw[2 * DFF2 + j];
        const float cg0 = cw[DFF + j], cg1 = cw[DFF2 + DFF + j], cg2 = cw[2 * DFF2 + DFF + j];
#pragma unroll
        for (int i = 0; i < 8; ++i) {
            const float val = cv0 * uv[i] + cv1 * uv[i + 1] + cv2 * uv[i + 2];
            const float gat = cg0 * ug[i] + cg1 * ug[i + 1] + cg2 * ug[i + 2];
            g[(size_t)(t0 + i) * DFF + j] = f2bf(silu_f(gat) * val);
        }
    }
}
__device__ __forceinline__ void ph_l1_prep(KArgs& a, int bid, int nb, int wv) {
    const bf16_t* z1 = (const bf16_t*)(a.ws + WS_Z1); const float* rope = (const float*)(a.ws + WS_ROPE);
    bf16_t* pl = (bf16_t*)(a.ws + WS_PL); float* rs = (float*)(a.ws + WS_RS); bf16_t* kr = (bf16_t*)(a.ws + WS_KR);
    const int lane = tid_opaque(wv) & 63, wave = tid_opaque(wv) >> 6;
    for (int t = bid * 8 + wave; t < S; t += nb * 8) {
        const bf16_t* zr = z1 + (size_t)t * ODD_IN_P;
        {
            const int c0 = lane * 8, win = 2 << (lane >> 4);
            const int lo = (t + 1 - win) > 0 ? (t + 1 - win) : 0;
            float sm[8];
#pragma unroll
            for (int e = 0; e < 8; ++e) sm[e] = 0.f;
            for (int r = lo; r <= t; ++r) {
                const uint4 u = *(const uint4*)(z1 + (size_t)r * ODD_IN_P + c0);
                sm[0] += bflo(u.x); sm[1] += bfhi(u.x); sm[2] += bflo(u.y); sm[3] += bfhi(u.y); sm[4] += bflo(u.z); sm[5] += bfhi(u.z); sm[6] += bflo(u.w); sm[7] += bfhi(u.w);
            }
            const float ic = 1.f / (float)(t + 1 - lo);
            const uint4 u = *(const uint4*)(zr + c0);
            uint4 o; o.x = pk2(sm[0] * ic - bflo(u.x), sm[1] * ic - bfhi(u.x)); o.y = pk2(sm[2] * ic - bflo(u.y), sm[3] * ic - bfhi(u.y));
            o.z = pk2(sm[4] * ic - bflo(u.z), sm[5] * ic - bfhi(u.z)); o.w = pk2(sm[6] * ic - bflo(u.w), sm[7] * ic - bfhi(u.w));
            *(uint4*)(pl + (size_t)t * 512 + c0) = o;
        }
        {
            float sq = 0.f;
#pragma unroll
            for (int j = 0; j < 3; ++j) { const unsigned u = *(const unsigned*)(zr + 512 + 128 * j + lane * 2); sq += bflo(u) * bflo(u) + bfhi(u) * bfhi(u); }
            sq = wave_sum(sq);
            const uint2 u2 = *(const uint2*)(zr + 896 + lane * 4);
            float sk = bflo(u2.x) * bflo(u2.x) + bfhi(u2.x) * bfhi(u2.x) + bflo(u2.y) * bflo(u2.y) + bfhi(u2.y) * bfhi(u2.y);
            sk = wave_sum(sk);
            if (lane == 0) { rs[(size_t)t * 2] = 1.f / sqrtf(sq * (1.f / 384.f) + RMS_EPS); rs[(size_t)t * 2 + 1] = 1.f / sqrtf(sk * (1.f / 256.f) + RMS_EPS); }
        }
        if (lane < 16) {
            const float x1 = bf2f(zr[1152 + lane]), x2 = bf2f(zr[1168 + lane]);
            const float c = rope[(size_t)t * 16 + lane], s = rope[(size_t)S * 16 + (size_t)t * 16 + lane];
            *(unsigned*)(kr + (size_t)t * 32 + 2 * lane) = pk2(x1 * c - x2 * s, x2 * c + x1 * s);
        }
    }
}
__device__ __forceinline__ void nv_mla(KArgs& a, unsigned char* lds, int t, int h, int wv) {
    const bf16_t* q1 = (const bf16_t*)(a.ws + WS_Q1); const bf16_t* k1 = (const bf16_t*)(a.ws + WS_K1); const bf16_t* kr = (const bf16_t*)(a.ws + WS_KR);
    const bf16_t* vt = (const bf16_t*)(a.ws + WS_VT); bf16_t* y = (bf16_t*)(a.ws + WS_Y1);
    LAS float* lg = lptr<float>(lds, 0);
    LAS float* qs = lptr<float>(lds, 65536);
    LAS float* red = lptr<float>(lds, 65536 + 512);
    const int tid = tid_opaque(wv), lane = tid & 63, wq = tid >> 6;
    const int N = (t / 64 + 1) * 64;
    if (tid < 96) qs[tid] = bf2f(q1[(size_t)t * 768 + h * 96 + tid]);
    __syncthreads();
    float m = -3.0e38f;
    for (int s = tid; s < N; s += NT) {
        asm volatile("" ::: "memory");
        const uint4* kp = (const uint4*)(k1 + (size_t)s * 512 + h * 64);
        float d = 0.f;
#pragma unroll
        for (int j = 0; j < 8; ++j) d += dot8q(qs + j * 8, kp[j]);
        const uint4* rp = (const uint4*)(kr + (size_t)s * 32);
#pragma unroll
        for (int j = 0; j < 4; ++j) d += dot8q(qs + 64 + j * 8, rp[j]);
        lg[s] = d; m = fmaxf(m, d);
    }
    m = wave_max(m);
    if (lane == 0) red[wq] = m;
    __syncthreads();
    m = red[0];
#pragma unroll
    for (int q = 1; q < 8; ++q) m = fmaxf(m, red[q]);
    __syncthreads();
    float sum = 0.f;
    for (int s = tid; s < N; s += NT) { const float pp = exp2f(lg[s] - m); lg[s] = pp; sum += pp; }
    sum = wave_sum(sum);
    if (lane == 0) red[wq] = sum;
    __syncthreads();
    float tot = 0.f;
#pragma unroll
    for (int q = 0; q < 8; ++q) tot += red[q];
    const float inv = 1.f / tot;
    for (int dd = 0; dd < 8; ++dd) {
        const int d = wq * 8 + dd;
        const bf16_t* vp = vt + (size_t)(h * 64 + d) * S;
        float acc = 0.f;
        for (int s = lane; s < N; s += 64) acc += lg[s] * bf2f(vp[s]);
        acc = wave_sum(acc);
        if (lane == 0) y[(size_t)t * 1024 + 512 + h * 64 + d] = f2bf(acc * inv);
    }
    __syncthreads();
}

typedef short mla_bf16x8 __attribute__((ext_vector_type(8)));
typedef float mla_f32x16 __attribute__((ext_vector_type(16)));
typedef float mla_f32x2 __attribute__((ext_vector_type(2)));
typedef __bf16 mla_bf16x2 __attribute__((ext_vector_type(2)));
typedef unsigned u32x4v __attribute__((ext_vector_type(4)));
typedef unsigned u32x2v __attribute__((ext_vector_type(2)));
constexpr int MLA_KSTR = 208, MLA_VSTR = 136, MLA_KBUF = 64 * MLA_KSTR, MLA_BUF = MLA_KBUF + 64 * MLA_VSTR;
__device__ __forceinline__ unsigned cvt2bf(float lo, float hi) { mla_f32x2 v = {lo, hi}; return __builtin_bit_cast(unsigned, __builtin_convertvector(v, mla_bf16x2)); }
__device__ __forceinline__ void mla_unit(const bf16_t* __restrict__ q1, const bf16_t* __restrict__ k1, const bf16_t* __restrict__ kr, const bf16_t* __restrict__ vt, bf16_t* __restrict__ y,
                                         unsigned char* lds, int h, int qb, int wv) {
    const int tid = tid_opaque(wv), lane = tid & 63, w = tid >> 6, l31 = lane & 31, hh = lane >> 5;
    LAS unsigned char* L = lptr<unsigned char>(lds, 0);
    const int tq = 256 * qb + 32 * w + l31;
    mla_bf16x8 qf[6];
#pragma unroll
    for (int ks = 0; ks < 6; ++ks) qf[ks] = *(const mla_bf16x8*)(q1 + (size_t)tq * 768 + h * 96 + ks * 16 + 8 * hh);
    const int ntiles = 4 * qb + 4, mytiles = 4 * qb + (w >> 1) + 1;
    const int rk = tid >> 3, ck = tid & 7, rr = (tid & 255) >> 2, cr = tid & 3;
    const bf16_t* gk = k1 + (size_t)rk * 512 + h * 64 + ck * 8;
    const bf16_t* gr = kr + (size_t)rr * 32 + cr * 8;
    const bf16_t* gv = vt + (size_t)(h * 64 + rk) * S + ck * 8;
    const int dk = rk * MLA_KSTR + ck * 16, dr = rr * MLA_KSTR + 128 + cr * 16, dv = MLA_KBUF + rk * MLA_VSTR + ck * 16;
    u32x4v sk, sr, sv;
    sk = *(const u32x4v*)gk; sv = *(const u32x4v*)gv; if (tid < 256) sr = *(const u32x4v*)gr;
    *(LAS u32x4v*)(L + dk) = sk; if (tid < 256) *(LAS u32x4v*)(L + dr) = sr;
    *(LAS u32x2v*)(L + dv) = (u32x2v){sv[0], sv[1]}; *(LAS u32x2v*)(L + dv + 8) = (u32x2v){sv[2], sv[3]};
    __syncthreads();
    mla_f32x16 o0, o1;
#pragma unroll
    for (int r = 0; r < 16; ++r) { o0[r] = 0.f; o1[r] = 0.f; }
    float m = -1.0e30f, l = 0.f;
    for (int j = 0; j < ntiles; ++j) {
        const bool more = (j + 1 < ntiles);
        if (more) {
            const size_t s0 = (size_t)(j + 1) * 64;
            sk = *(const u32x4v*)(gk + s0 * 512); sv = *(const u32x4v*)(gv + s0); if (tid < 256) sr = *(const u32x4v*)(gr + s0 * 32);
        }
        if (j < mytiles) {
            const LAS unsigned char* Kb = L + (j & 1) * MLA_BUF; const LAS unsigned char* Vb = Kb + MLA_KBUF;
            mla_f32x16 s0v, s1v;
#pragma unroll
            for (int r = 0; r < 16; ++r) { s0v[r] = 0.f; s1v[r] = 0.f; }
#pragma unroll
            for (int ks = 0; ks < 6; ++ks) {
                const mla_bf16x8 a0 = *(const LAS mla_bf16x8*)(Kb + l31 * MLA_KSTR + (ks * 16 + 8 * hh) * 2);
                const mla_bf16x8 a1 = *(const LAS mla_bf16x8*)(Kb + (32 + l31) * MLA_KSTR + (ks * 16 + 8 * hh) * 2);
                s0v = __builtin_amdgcn_mfma_f32_32x32x16_bf16(a0, qf[ks], s0v, 0, 0, 0);
                s1v = __builtin_amdgcn_mfma_f32_32x32x16_bf16(a1, qf[ks], s1v, 0, 0, 0);
            }
            float mx = fmaxf(s0v[0], s1v[0]);
#pragma unroll
            for (int r = 1; r < 16; ++r) mx = fmaxf(mx, fmaxf(s0v[r], s1v[r]));
            mx = fmaxf(mx, __shfl_xor(mx, 32));
            const float mn = fmaxf(m, mx), alpha = __builtin_amdgcn_exp2f(m - mn);
            m = mn;
            float rs = 0.f;
#pragma unroll
            for (int r = 0; r < 16; ++r) { s0v[r] = __builtin_amdgcn_exp2f(s0v[r] - mn); s1v[r] = __builtin_amdgcn_exp2f(s1v[r] - mn); rs += s0v[r] + s1v[r]; }
            l = l * alpha + rs;
#pragma unroll
            for (int r = 0; r < 16; ++r) { o0[r] *= alpha; o1[r] *= alpha; }
#pragma unroll
            for (int kb = 0; kb < 2; ++kb)
#pragma unroll
                for (int sx = 0; sx < 2; ++sx) {
                    u32x4v pw;
                    if (kb == 0) { pw[0] = cvt2bf(s0v[8 * sx + 0], s0v[8 * sx + 1]); pw[1] = cvt2bf(s0v[8 * sx + 2], s0v[8 * sx + 3]); pw[2] = cvt2bf(s0v[8 * sx + 4], s0v[8 * sx + 5]); pw[3] = cvt2bf(s0v[8 * sx + 6], s0v[8 * sx + 7]); }
                    else         { pw[0] = cvt2bf(s1v[8 * sx + 0], s1v[8 * sx + 1]); pw[1] = cvt2bf(s1v[8 * sx + 2], s1v[8 * sx + 3]); pw[2] = cvt2bf(s1v[8 * sx + 4], s1v[8 * sx + 5]); pw[3] = cvt2bf(s1v[8 * sx + 6], s1v[8 * sx + 7]); }
                    const mla_bf16x8 pb = __builtin_bit_cast(mla_bf16x8, pw);
                    const int kbase = (32 * kb + 16 * sx + 4 * hh) * 2;
                    {   const u32x2v lo = *(const LAS u32x2v*)(Vb + l31 * MLA_VSTR + kbase), hi = *(const LAS u32x2v*)(Vb + l31 * MLA_VSTR + kbase + 16);
                        u32x4v aw = {lo[0], lo[1], hi[0], hi[1]};
                        o0 = __builtin_amdgcn_mfma_f32_32x32x16_bf16(__builtin_bit_cast(mla_bf16x8, aw), pb, o0, 0, 0, 0); }
                    {   const u32x2v lo = *(const LAS u32x2v*)(Vb + (32 + l31) * MLA_VSTR + kbase), hi = *(const LAS u32x2v*)(Vb + (32 + l31) * MLA_VSTR + kbase + 16);
                        u32x4v aw = {lo[0], lo[1], hi[0], hi[1]};
                        o1 = __builtin_amdgcn_mfma_f32_32x32x16_bf16(__builtin_bit_cast(mla_bf16x8, aw), pb, o1, 0, 0, 0); }
                }
        }
        if (more) {
            LAS unsigned char* Nb = L + ((j + 1) & 1) * MLA_BUF;
            *(LAS u32x4v*)(Nb + dk) = sk; if (tid < 256) *(LAS u32x4v*)(Nb + dr) = sr;
            *(LAS u32x2v*)(Nb + dv) = (u32x2v){sv[0], sv[1]}; *(LAS u32x2v*)(Nb + dv + 8) = (u32x2v){sv[2], sv[3]};
        }
        __syncthreads();
    }
    l += __shfl_xor(l, 32);
    const float inv = 1.f / l;
    bf16_t* yo = y + (size_t)tq * 1024 + 512 + h * 64 + 4 * hh;
#pragma unroll
    for (int g4 = 0; g4 < 4; ++g4) {
        uint2 w0, w1;
        w0.x = cvt2bf(o0[4 * g4] * inv, o0[4 * g4 + 1] * inv); w0.y = cvt2bf(o0[4 * g4 + 2] * inv, o0[4 * g4 + 3] * inv);
        w1.x = cvt2bf(o1[4 * g4] * inv, o1[4 * g4 + 1] * inv); w1.y = cvt2bf(o1[4 * g4 + 2] * inv, o1[4 * g4 + 3] * inv);
        *(uint2*)(yo + 8 * g4) = w0; *(uint2*)(yo + 32 + 8 * g4) = w1;
    }
}
__device__ __forceinline__ void ph_mla(KArgs& a, unsigned char* lds, int bid, int nb, int wv) {
    const bf16_t* q1 = (const bf16_t*)(a.ws + WS_Q1); const bf16_t* k1 = (const bf16_t*)(a.ws + WS_K1); const bf16_t* kr = (const bf16_t*)(a.ws + WS_KR);
    const bf16_t* vt = (const bf16_t*)(a.ws + WS_VT); bf16_t* y = (bf16_t*)(a.ws + WS_Y1);
    for (int u = bid; u < 256; u += nb) {
        const int h = u & 7, qbp = u >> 3;
        mla_unit(q1, k1, kr, vt, y, lds, h, qbp, wv);
        mla_unit(q1, k1, kr, vt, y, lds, h, 63 - qbp, wv);
    }
}

typedef _Float16 f16x8 __attribute__((ext_vector_type(8)));
typedef __bf16 dsa_bf16x2 __attribute__((ext_vector_type(2)));
constexpr int DS_HIST = 0, DS_PART = 65536, DS_T0 = 67584, DS_T1 = 67712, DS_GT = 67840, DS_SEL = 67968, DS_BC = 68096, DS_BL = 68608, DS_IDX = 84992, DS_END = 101376;
constexpr int DS_BLCAP = 64;
template <int CTRL> __device__ __forceinline__ float dppx(float x) { return __builtin_bit_cast(float, __builtin_amdgcn_mov_dpp(__builtin_bit_cast(int, x), CTRL, 0xf, 0xf, true)); }
__device__ __forceinline__ float grp8_sum(float v) { v += dppx<0xB1>(v); v += dppx<0x4E>(v); v += dppx<0x141>(v); return v; }
__device__ __forceinline__ float grp8_max(float v) { v = fmaxf(v, dppx<0xB1>(v)); v = fmaxf(v, dppx<0x4E>(v)); v = fmaxf(v, dppx<0x141>(v)); return v; }
__device__ __forceinline__ float dot2bf(unsigned a, unsigned b, float c) { return __builtin_amdgcn_fdot2_f32_bf16(__builtin_bit_cast(dsa_bf16x2, a), __builtin_bit_cast(dsa_bf16x2, b), c, false); }

typedef float f32x4v __attribute__((ext_vector_type(4)));
constexpr int DS_SB = 2, DS_SUP = 16 * DS_SB;
__device__ __forceinline__ void dsa_load_a(const f16_t* __restrict__ ki, int key0, int l15, int kg, f16x8 (&a)[DS_SB][2]) {
#pragma unroll
    for (int sb = 0; sb < DS_SB; ++sb) {
        const f16_t* kp = ki + (size_t)(key0 + 16 * sb + l15) * 64 + 8 * kg;
        a[sb][0] = *(const f16x8*)kp; a[sb][1] = *(const f16x8*)(kp + 32);
    }
}
__device__ __forceinline__ void dsa_score(const f16x8 (&a)[DS_SB][2], const f16x8 (&qf)[8][2], const f16x8 (&uf)[2], const float (&w)[8], f32x4v (&sc)[DS_SB]) {
#pragma unroll
    for (int sb = 0; sb < DS_SB; ++sb) {
        f32x4v acc = {0.f, 0.f, 0.f, 0.f};
        acc = __builtin_amdgcn_mfma_f32_16x16x32_f16(a[sb][0], uf[0], acc, 0, 0, 0);
        sc[sb] = __builtin_amdgcn_mfma_f32_16x16x32_f16(a[sb][1], uf[1], acc, 0, 0, 0);
    }
#pragma unroll
    for (int h = 0; h < 8; ++h) {
        f32x4v x[DS_SB];
#pragma unroll
        for (int sb = 0; sb < DS_SB; ++sb) {
            f32x4v z = {0.f, 0.f, 0.f, 0.f};
            z = __builtin_amdgcn_mfma_f32_16x16x32_f16(a[sb][0], qf[h][0], z, 0, 0, 0);
            x[sb] = __builtin_amdgcn_mfma_f32_16x16x32_f16(a[sb][1], qf[h][1], z, 0, 0, 0);
        }
#pragma unroll
        for (int sb = 0; sb < DS_SB; ++sb)
#pragma unroll
            for (int r = 0; r < 4; ++r) sc[sb][r] = fmaf(fabsf(x[sb][r]), w[h], sc[sb][r]);
    }
}
__device__ __forceinline__ void dsa_unit(KArgs& a, unsigned char* lds, int c, int hf, int wv) {
    unsigned char* ws = a.ws;
    const f16_t* qi = (const f16_t*)(ws + WS_QI); const f16_t* ki = (const f16_t*)(ws + WS_KI); const float* wi = (const float*)(ws + WS_WI);
    const bf16_t* q0 = (const bf16_t*)(ws + WS_Q0); const bf16_t* k0 = (const bf16_t*)(ws + WS_K0); const bf16_t* v0 = (const bf16_t*)(ws + WS_V0); bf16_t* y = (bf16_t*)(ws + WS_Y0);
    const int tid = tid_opaque(wv), lane = tid & 63, w = tid >> 6, l15 = lane & 15, kg = lane >> 4;
    const int grp = w >> 2, wg = w & 3, q32 = 16 * grp + l15;
    const int t0 = 64 * c + 32 * hf, N = 64 * (c + 1), nsup = N / DS_SUP;
    LAS unsigned char* L = lptr<unsigned char>(lds, 0);
    LAS unsigned* HIST = (LAS unsigned*)(L + DS_HIST); LAS float* PART = (LAS float*)(L + DS_PART);
    LAS float* T0 = (LAS float*)(L + DS_T0); LAS float* T1 = (LAS float*)(L + DS_T1); LAS unsigned* GT = (LAS unsigned*)(L + DS_GT);
    LAS unsigned* SEL = (LAS unsigned*)(L + DS_SEL); LAS unsigned* BC = (LAS unsigned*)(L + DS_BC);
    LAS u32x2v* BL = (LAS u32x2v*)(L + DS_BL); LAS unsigned short* IDXL = (LAS unsigned short*)(L + DS_IDX);
    if (N <= TOPK) {
        for (int e = tid; e < 32 * N; e += NT) { const int q = e / N, j = e - q * N; IDXL[q * 256 + j] = (unsigned short)j; }
        __syncthreads();
    } else {
        f16x8 qf[8][2], uf[2]; float wq[8];
        {
            const f16_t* qp = qi + (size_t)(t0 + q32) * 512 + 8 * kg;
#pragma unroll
            for (int h = 0; h < 8; ++h) { wq[h] = wi[(size_t)(t0 + q32) * 8 + h]; qf[h][0] = *(const f16x8*)(qp + h * 64); qf[h][1] = *(const f16x8*)(qp + h * 64 + 32); }
#pragma unroll
            for (int ks = 0; ks < 2; ++ks) {
                f16x8 u;
#pragma unroll
                for (int e = 0; e < 8; ++e) { float sacc = 0.f;
#pragma unroll
                    for (int h = 0; h < 8; ++h) sacc = fmaf(wq[h], (float)qf[h][ks][e], sacc);
                    u[e] = (f16_t)sacc; }
                uf[ks] = u;
                __builtin_amdgcn_sched_barrier(0);
            }
        }
        for (int e = tid; e < 32 * 512; e += NT) HIST[e] = 0u;
        if (tid < 32) { SEL[tid] = 0u; BC[tid] = 0u; }
        f32x4v sc[DS_SB]; f16x8 ac[DS_SB][2];
        dsa_load_a(ki, DS_SUP * wg, l15, kg, ac);
        dsa_score(ac, qf, uf, wq, sc);
        {
            float s1 = 0.f, s2 = 0.f;
#pragma unroll
            for (int sb = 0; sb < DS_SB; ++sb)
#pragma unroll
                for (int r = 0; r < 4; ++r) { s1 += sc[sb][r]; s2 = fmaf(sc[sb][r], sc[sb][r], s2); }
            s1 += __shfl_xor(s1, 16); s2 += __shfl_xor(s2, 16); s1 += __shfl_xor(s1, 32); s2 += __shfl_xor(s2, 32);
            if (kg == 0) { PART[(wg * 32 + q32) * 2] = s1; PART[(wg * 32 + q32) * 2 + 1] = s2; }
        }
        __syncthreads();
        float inv, c0;
        {
            float s1 = 0.f, s2 = 0.f;
#pragma unroll
            for (int q = 0; q < 4; ++q) { s1 += PART[(q * 32 + q32) * 2]; s2 += PART[(q * 32 + q32) * 2 + 1]; }
            const float mu = s1 * (1.f / (4 * DS_SUP)), var = fmaxf(s2 * (1.f / (4 * DS_SUP)) - mu * mu, 1e-30f);
            inv = 64.f / sqrtf(var); c0 = 192.f - mu * inv;
        }
#pragma unroll 1
        for (int J = wg; J < nsup; J += 4) {
            dsa_load_a(ki, DS_SUP * J, l15, kg, ac);
            dsa_score(ac, qf, uf, wq, sc);
#pragma unroll
            for (int sb = 0; sb < DS_SB; ++sb)
#pragma unroll
                for (int r = 0; r < 4; ++r) {
                    const float g = fmaf(sc[sb][r], inv, c0);
                    int b = (int)floorf(g); b = b < 0 ? 0 : (b > 511 ? 511 : b);
                    __hip_atomic_fetch_add(HIST + q32 * 512 + b, 1u, __ATOMIC_RELAXED, __HIP_MEMORY_SCOPE_WORKGROUP);
                }
        }
        __syncthreads();
#pragma unroll 1
        for (int qq = 0; qq < 4; ++qq) {
            const int q = 4 * w + qq;
            const u32x4v h0 = *(const LAS u32x4v*)(HIST + q * 512 + 8 * lane), h1 = *(const LAS u32x4v*)(HIST + q * 512 + 8 * lane + 4);
            const unsigned hv[8] = {h0[0], h0[1], h0[2], h0[3], h1[0], h1[1], h1[2], h1[3]};
            const unsigned cl = (h0[0] + h0[1]) + (h0[2] + h0[3]) + (h1[0] + h1[1]) + (h1[2] + h1[3]);
            unsigned sfx = cl;
#pragma unroll
            for (int off = 1; off < 64; off <<= 1) { const unsigned tt = __shfl_down(sfx, off); if (lane + off < 64) sfx += tt; }
            const unsigned long long mk = __ballot(sfx >= (unsigned)TOPK);
            const int istar = 63 - __clzll(mk);
            unsigned run = sfx - cl, gt = 0u; int bstar = -1;
#pragma unroll
            for (int k = 7; k >= 0; --k) { const unsigned nr = run + hv[k]; if (bstar < 0 && nr >= (unsigned)TOPK) { bstar = 8 * lane + k; gt = run; } run = nr; }
            if (lane == istar) { T1[q] = (bstar == 511) ? 3.0e38f : (float)(bstar + 1); T0[q] = (bstar == 0) ? -3.0e38f : (float)bstar; GT[q] = gt; }
        }
        __syncthreads();
        {
            const float t1 = T1[q32], t0f = T0[q32];
    #pragma unroll 1
        for (int J = wg; J < nsup; J += 4) {
                dsa_load_a(ki, DS_SUP * J, l15, kg, ac);
                dsa_score(ac, qf, uf, wq, sc);
#pragma unroll
                for (int sb = 0; sb < DS_SB; ++sb)
#pragma unroll
                    for (int r = 0; r < 4; ++r) {
                        const float g = fmaf(sc[sb][r], inv, c0);
                        const int key = DS_SUP * J + 16 * sb + 4 * kg + r;
                        if (g >= t1) { const unsigned pos = __hip_atomic_fetch_add(SEL + q32, 1u, __ATOMIC_RELAXED, __HIP_MEMORY_SCOPE_WORKGROUP); if (pos < 256u) IDXL[q32 * 256 + pos] = (unsigned short)key; }
                        else if (g >= t0f) { const unsigned bp = __hip_atomic_fetch_add(BC + q32, 1u, __ATOMIC_RELAXED, __HIP_MEMORY_SCOPE_WORKGROUP);
                            if (bp < (unsigned)DS_BLCAP) BL[q32 * DS_BLCAP + bp] = (u32x2v){__float_as_uint(sc[sb][r]), (unsigned)key}; }
                    }
            }
        }
        __syncthreads();
#pragma unroll 1
        for (int qq = 0; qq < 4; ++qq) {
            const int q = 4 * w + qq;
            const unsigned nbl = BC[q] < (unsigned)DS_BLCAP ? BC[q] : (unsigned)DS_BLCAP, gt = GT[q], need = (unsigned)TOPK - gt;
            const u32x2v me = BL[q * DS_BLCAP + (lane < (int)nbl ? lane : 0)];
            const float sme = __uint_as_float(me[0]);
            unsigned rank = 0u;
            for (unsigned i2 = 0; i2 < nbl; ++i2) { const u32x2v o = BL[q * DS_BLCAP + i2]; const float so = __uint_as_float(o[0]); rank += (so > sme || (so == sme && o[1] < me[1])) ? 1u : 0u; }
            if (lane < (int)nbl && rank < need) IDXL[q * 256 + gt + rank] = (unsigned short)me[1];
        }
        __syncthreads();
    }
    int ln = lane; asm volatile("" : "+v"(ln));
    const int cnt = N < TOPK ? N : TOPK, head = ln >> 3;
    const float slope = exp2f(-(float)(head + 1));
    LAS float* P = (LAS float*)(L + DS_HIST + w * 8192);
    LAS unsigned* P2 = (LAS unsigned*)P;
#pragma unroll 1
    for (int qq = 0; qq < 4; ++qq) {
        const int q = 4 * w + qq, t = t0 + q;
        const LAS unsigned short* il = IDXL + q * 256;
        const u32x4v qv = *(const u32x4v*)(q0 + (size_t)t * 512 + 8 * ln);
        for (int j0 = 0; j0 < cnt; j0 += 8) {
            int id[8]; u32x4v kv[8];
#pragma unroll
            for (int k = 0; k < 8; ++k) { id[k] = __builtin_amdgcn_readfirstlane((int)il[j0 + k]); kv[k] = *(const u32x4v*)(k0 + (size_t)id[k] * 512 + 8 * ln); }
#pragma unroll
            for (int k = 0; k < 8; ++k) {
                float d = dot2bf(kv[k][0], qv[0], 0.f); d = dot2bf(kv[k][1], qv[1], d); d = dot2bf(kv[k][2], qv[2], d); d = dot2bf(kv[k][3], qv[3], d);
                d = grp8_sum(d);
                d -= slope * fabsf((float)(t - id[k]));
                if ((ln & 7) == 0) P[head * 256 + j0 + k] = d;
            }
        }
        asm volatile("s_waitcnt lgkmcnt(0)" ::: "memory");
        float pv0[16], pv1[16]; float mx = -3.0e38f;
        const int npair8 = cnt >> 4;
#pragma unroll
        for (int i = 0; i < 16; ++i) {
            if (i < npair8) { const mla_f32x2 two = *(const LAS mla_f32x2*)(P + head * 256 + 2 * ((ln & 7) + 8 * i)); pv0[i] = two[0]; pv1[i] = two[1]; mx = fmaxf(mx, fmaxf(two[0], two[1])); }
            else { pv0[i] = -3.0e38f; pv1[i] = -3.0e38f; }
        }
        mx = grp8_max(mx);
        float sm = 0.f;
#pragma unroll
        for (int i = 0; i < 16; ++i) {
            const float e0 = (i < npair8) ? __builtin_amdgcn_exp2f((pv0[i] - mx) * 1.4426950408889634f) : 0.f, e1 = (i < npair8) ? __builtin_amdgcn_exp2f((pv1[i] - mx) * 1.4426950408889634f) : 0.f;
            sm += e0 + e1; pv0[i] = e0; pv1[i] = e1;
        }
        sm = grp8_sum(sm);
        asm volatile("s_waitcnt lgkmcnt(0)" ::: "memory");
#pragma unroll
        for (int i = 0; i < 16; ++i) if (i < npair8) P2[head * 128 + (ln & 7) + 8 * i] = cvt2bf(pv0[i], pv1[i]);
        asm volatile("s_waitcnt lgkmcnt(0)" ::: "memory");
        float oacc[8];
#pragma unroll
        for (int e = 0; e < 8; ++e) oacc[e] = 0.f;
        for (int p0 = 0; p0 < (cnt >> 1); p0 += 4) {
            u32x4v va[4], vb[4]; unsigned pp[4];
#pragma unroll
            for (int k = 0; k < 4; ++k) {
                const int ia = __builtin_amdgcn_readfirstlane((int)il[2 * (p0 + k)]), ib = __builtin_amdgcn_readfirstlane((int)il[2 * (p0 + k) + 1]);
                va[k] = *(const u32x4v*)(v0 + (size_t)ia * 512 + 8 * ln); vb[k] = *(const u32x4v*)(v0 + (size_t)ib * 512 + 8 * ln);
                pp[k] = P2[head * 128 + p0 + k];
            }
#pragma unroll
            for (int k = 0; k < 4; ++k)
#pragma unroll
                for (int wd = 0; wd < 4; ++wd) {
                    const unsigned lo = (va[k][wd] & 0xffffu) | (vb[k][wd] << 16), hi = (va[k][wd] >> 16) | (vb[k][wd] & 0xffff0000u);
                    oacc[2 * wd] = dot2bf(lo, pp[k], oacc[2 * wd]); oacc[2 * wd + 1] = dot2bf(hi, pp[k], oacc[2 * wd + 1]);
                }
        }
        const float isum = 1.f / sm;
        u32x4v ov; ov[0] = cvt2bf(oacc[0] * isum, oacc[1] * isum); ov[1] = cvt2bf(oacc[2] * isum, oacc[3] * isum); ov[2] = cvt2bf(oacc[4] * isum, oacc[5] * isum); ov[3] = cvt2bf(oacc[6] * isum, oacc[7] * isum);
        *(u32x4v*)(y + (size_t)t * 1024 + 8 * ln) = ov;
        asm volatile("s_waitcnt lgkmcnt(0)" ::: "memory");
    }
    __syncthreads();
}
__device__ __forceinline__ void ph_dsa(KArgs& a, unsigned char* lds, int bid, int nb, int wv) {
    for (int u = bid; u < 256; u += nb) {
        const int hf = u & 1, cp = u >> 1;
        dsa_unit(a, lds, cp, hf, wv);
        dsa_unit(a, lds, 255 - cp, hf, wv);
    }
}

constexpr int N_PHASES = 20;
__global__ void __launch_bounds__(NT, 2) mega(Args  ) {
    extern __shared__ __attribute__((aligned(16))) unsigned char lds[];
    const int wv = __builtin_amdgcn_readfirstlane((int)threadIdx.x >> 6);
    const int tid = tid_opaque(wv), bid = blockIdx.x, nb = gridDim.x;
    for (int u = tid; u < (LDS_BYTES - LDSCTL_OFF) / 4; u += NT) ((LAS unsigned*)((LAS unsigned char*)lds + LDSCTL_OFF))[u] = 0u;
    __syncthreads();
    volatile LAS unsigned* MISC = (volatile LAS unsigned*)((LAS unsigned char*)lds + MISC_OFF);
    const int ph_lo = kargs().ph_lo, ph_hi = kargs().ph_hi;
    XcdBarrier bar = xcd_barrier_post((unsigned*)(kargs().ws + WS_CTL) + CW_BAR, MISC + 8, wv);
#define IN(k) (ph_lo <= (k) && (k) < ph_hi)
#define SEAM(k) do { if (ph_lo <= (k) && (k) + 1 < ph_hi) xcd_barrier(bar); } while (0)
#define WSP(T, off) ((T*)(ws + (off)))

    if (IN(0)) { KArgs& a = kargs(); ph_mod(a, lds, bid, nb, wv); }
    SEAM(0);
    if (IN(1)) { KArgs& a = kargs(); ph_prep(a, lds, bid, nb, wv); }
    SEAM(1);
    if (IN(2)) { KArgs& a = kargs(); unsigned char* ws = a.ws;
        run_gemm(lds, WSP(const bf16_t, WS_XB), D, WSP(const bf16_t, WS_W_IN0), D, S, EVEN_IN_P, D,
                 EpiIn0{WSP(const float, WS_BIAS_IN0), WSP(bf16_t, WS_Q0), WSP(bf16_t, WS_K0), WSP(bf16_t, WS_V0), WSP(bf16_t, WS_BG), WSP(bf16_t, WS_CG), WSP(bf16_t, WS_XC),
                        WSP(f16_t, WS_QI), WSP(f16_t, WS_KI), WSP(float, WS_WI)}, nb, bid, wv); }
    SEAM(2);
    if (IN(3)) { KArgs& a = kargs();
        ph_shortconv(a, bid, nb, wv);
        ph_dsa(a, lds, bid, nb, wv);
    }
    SEAM(3);
    if (IN(4)) { KArgs& a = kargs(); unsigned char* ws = a.ws;
        run_gemm(lds, WSP(const bf16_t, WS_Y0), D, WSP(const bf16_t, WS_W_OUT0), D, S, D, D, EpiResid{a.x, a.out}, nb, bid, wv); }
    SEAM(4);
    if (IN(5)) { KArgs& a = kargs(); ph_ln(a.out, a.ln_mix_g, a.ln_mix_b, (bf16_t*)(a.ws + WS_XB), bid, nb, wv); }
    SEAM(5);
    if (IN(6)) { KArgs& a = kargs(); unsigned char* ws = a.ws;
        run_gemm_epi(lds, WSP(const bf16_t, WS_XB), D, WSP(const bf16_t, WS_W_UP0), D, S, DFF2, D, EpiFfnUp{WSP(const float, WS_BIAS_UP0), a.ffn_conv_w, WSP(bf16_t, WS_G), WSP(bf16_t, WS_HU)}, nb, bid, wv); }
    SEAM(6);
    if (IN(7)) { KArgs& a = kargs(); unsigned char* ws = a.ws; ph_ffn_fix(WSP(const bf16_t, WS_HU), a.ffn_conv_w, WSP(bf16_t, WS_G), bid, nb, wv); }
    SEAM(7);
    if (IN(8)) { KArgs& a = kargs(); unsigned char* ws = a.ws;
        run_gemm(lds, WSP(const bf16_t, WS_G), DFF, WSP(const bf16_t, WS_W_DN0), DFF, S, D, DFF, EpiResid{a.out, a.out}, nb, bid, wv); }
    SEAM(8);
    if (IN(9)) { KArgs& a = kargs(); ph_ln(a.out, a.ln_ffn_g, a.ln_ffn_b, (bf16_t*)(a.ws + WS_XB), bid, nb, wv); }
    SEAM(9);
    if (IN(10)) { KArgs& a = kargs(); unsigned char* ws = a.ws;
        run_gemm(lds, WSP(const bf16_t, WS_XB), D, WSP(const bf16_t, WS_W_IN1), D, S, ODD_IN_P, D, EpiBiasBf16{WSP(const float, WS_BIAS_IN1), WSP(bf16_t, WS_Z1), ODD_IN_P}, nb, bid, wv); }
    SEAM(10);
    if (IN(11)) { KArgs& a = kargs(); ph_l1_prep(a, bid, nb, wv); }
    SEAM(11);
    if (IN(12)) {
        { KArgs& a = kargs(); unsigned char* ws = a.ws;
          run_gemm(lds, WSP(const bf16_t, WS_PL), 512, WSP(const bf16_t, WS_W_POOL), 512, S, 512, 512, EpiPlainBf16{WSP(bf16_t, WS_Y1), 1024}, nb, bid, wv); }
        { KArgs& a = kargs(); unsigned char* ws = a.ws;
          run_gemm(lds, WSP(const bf16_t, WS_Z1) + 512, ODD_IN_P, WSP(const bf16_t, WS_W_UQ), 384, S, 768, 384, EpiQ1{WSP(const float, WS_RS), WSP(const float, WS_ROPE), WSP(bf16_t, WS_Q1)}, nb, bid, wv); }
        { KArgs& a = kargs(); unsigned char* ws = a.ws;
          run_gemm(lds, WSP(const bf16_t, WS_Z1) + 896, ODD_IN_P, WSP(const bf16_t, WS_W_UK), 256, S, 512, 256, EpiRowScaleBf16{WSP(const float, WS_RS), 1, WSP(bf16_t, WS_K1), 512}, nb, bid, wv); }
        { KArgs& a = kargs(); unsigned char* ws = a.ws;
          run_gemm(lds, WSP(const bf16_t, WS_W_UV), 256, WSP(const bf16_t, WS_Z1) + 896, ODD_IN_P, 512, S, 256, EpiColScaleBf16{WSP(const float, WS_RS), 1, WSP(bf16_t, WS_VT), S}, nb, bid, wv); }
    }
    SEAM(12);
    if (IN(13)) { KArgs& a = kargs(); ph_mla(a, lds, bid, nb, wv); }
    SEAM(13);
    if (IN(14)) { KArgs& a = kargs(); unsigned char* ws = a.ws;
        run_gemm(lds, WSP(const bf16_t, WS_Y1), D, WSP(const bf16_t, WS_W_OUT1), D, S, D, D, EpiResid{a.out, a.out}, nb, bid, wv); }
    SEAM(14);
    if (IN(15)) { KArgs& a = kargs(); ph_ln(a.out, a.ln_mix_g + D, a.ln_mix_b + D, (bf16_t*)(a.ws + WS_XB), bid, nb, wv); }
    SEAM(15);
    if (IN(16)) { KArgs& a = kargs(); unsigned char* ws = a.ws;
        run_gemm_epi(lds, WSP(const bf16_t, WS_XB), D, WSP(const bf16_t, WS_W_UP1), D, S, DFF2, D, EpiFfnUp{WSP(const float, WS_BIAS_UP1), a.ffn_conv_w + (size_t)3 * DFF2, WSP(bf16_t, WS_G), WSP(bf16_t, WS_HU)}, nb, bid, wv); }
    SEAM(16);
    if (IN(17)) { KArgs& a = kargs(); unsigned char* ws = a.ws; ph_ffn_fix(WSP(const bf16_t, WS_HU), a.ffn_conv_w + (size_t)3 * DFF2, WSP(bf16_t, WS_G), bid, nb, wv); }
    SEAM(17);
    if (IN(18)) { KArgs& a = kargs(); unsigned char* ws = a.ws;
        run_gemm(lds, WSP(const bf16_t, WS_G), DFF, WSP(const bf16_t, WS_W_DN1), DFF, S, D, DFF, EpiResid{a.out, a.out}, nb, bid, wv); }
    SEAM(18);
    if (IN(19)) { KArgs& a = kargs(); ph_ln(a.out, a.ln_ffn_g + D, a.ln_ffn_b + D, (bf16_t*)(a.ws + WS_XB), bid, nb, wv); }
#undef IN
#undef SEAM
#undef WSP
}

extern "C" void kernel_launch(void* const* d_in, const int* in_sizes, int n_in, void* d_out, int out_size, void* d_ws, size_t ws_size, hipStream_t stream) {
    static int grid = 0;
    if (grid == 0) {
        if (n_in != 22 || out_size != S * D || ws_size < WS_END) { fprintf(stderr, "kernel_launch: unexpected problem (n_in %d out %d ws %zu)\n", n_in, out_size, ws_size); grid = -1; return; }
        int dev = 0, cus = 0;
        if (hipGetDevice(&dev) != hipSuccess || hipDeviceGetAttribute(&cus, hipDeviceAttributeMultiprocessorCount, dev) != hipSuccess) { grid = -1; return; }
        if (hipFuncSetAttribute((const void*)mega, hipFuncAttributeMaxDynamicSharedMemorySize, LDS_BYTES) != hipSuccess) { fprintf(stderr, "kernel_launch: hipFuncSetAttribute failed\n"); grid = -1; return; }
        grid = cus;
    }
    if (grid < 0) return;
    if (hipMemsetAsync((char*)d_ws + WS_CTL, 0, CTL_ZERO_BYTES, stream) != hipSuccess) return;
    Args a{};
    const float** ap = (const float**)&a;
    for (int i = 0; i < 22; ++i) ap[i] = (const float*)d_in[i];
    a.out = (float*)d_out; a.ws = (unsigned char*)d_ws;
#if MK_SPLIT
    for (int p = 0; p < N_PHASES; ++p) { a.ph_lo = p; a.ph_hi = p + 1; hipLaunchKernelGGL(mega, dim3(grid), dim3(NT), LDS_BYTES, stream, a); }
#else
    a.ph_lo = 0; a.ph_hi = N_PHASES;
    hipLaunchKernelGGL(mega, dim3(grid), dim3(NT), LDS_BYTES, stream, a);
#endif
}
```
